# Optimizing an MI355X kernel written in HIP

```python
import jax, jax.numpy as jnp
from jax import lax
import numpy as np

D_MODEL = 1024
BATCH = 8
SEQ = 2048
DEPTH = 4

RET_HEADS = 4
RET_QK_DIM = 256
RET_V_DIM = 512
RET_CHUNK = 128
RET_IN = 2 * RET_HEADS * RET_QK_DIM + 2 * RET_HEADS * RET_V_DIM
ATT_Q_HEADS = 16
ATT_KV_HEADS = 4
ATT_GROUP = ATT_Q_HEADS // ATT_KV_HEADS
ATT_HEAD_DIM = 64
WINDOW = 128
ATT_IN = (ATT_Q_HEADS + 2 * ATT_KV_HEADS) * ATT_HEAD_DIM
D_FF = 4 * D_MODEL
N_MIXERS = 2
N_RET_LAYERS = (DEPTH + 1) // 2
N_ATT_LAYERS = DEPTH // 2
EPS = 1e-6
NEG_INF = -1e30

kernel_name = "hybrid_retention_swa_sink_alibi_encoder"


def rms_norm(x, g):
    xf = x.astype(jnp.float32)
    y = xf * lax.rsqrt(jnp.mean(xf * xf, axis=-1, keepdims=True) + EPS)
    return (y * g.astype(jnp.float32)).astype(x.dtype)


def retention_one_direction(q, k, v, log_gamma, strict):
    B, H, S, dk = q.shape
    dv = v.shape[-1]
    C = RET_CHUNK
    n = S // C
    lg = log_gamma.astype(jnp.float32)
    idx = jnp.arange(C, dtype=jnp.float32)
    diff = idx[:, None] - idx[None, :]
    mask = diff > 0 if strict else diff >= 0
    inner_decay = jnp.where(mask[None], jnp.exp(lg[:, None, None] * jnp.where(mask, diff, 0.0)[None]), 0.0)
    q_decay = jnp.exp(lg[:, None] * (idx + 1.0)[None])
    k_decay = jnp.exp(lg[:, None] * (C - 1.0 - idx)[None])
    chunk_decay = jnp.exp(lg * C)

    def to_chunks(a):
        return a.reshape(B, H, n, C, a.shape[-1]).transpose(2, 0, 1, 3, 4)

    def step(R, inp):
        qi, ki, vi = inp
        s = jnp.einsum('bhid,bhjd->bhij', qi, ki) * inner_decay
        inner = jnp.einsum('bhij,bhjv->bhiv', s, vi)
        cross = jnp.einsum('bhid,bhdv->bhiv', qi * q_decay[..., None], R)
        R_new = R * chunk_decay[:, None, None] + jnp.einsum('bhjd,bhjv->bhdv', ki * k_decay[..., None], vi)
        return R_new, inner + cross

    R0 = jnp.zeros((B, H, dk, dv), jnp.float32)
    _, out = lax.scan(step, R0, (to_chunks(q), to_chunks(k), to_chunks(v)))
    return out.transpose(1, 2, 0, 3, 4).reshape(B, H, S, dv)


def retention_mixer(h, w_in, w_out, log_decay_fwd, log_decay_bwd):
    B, S, _ = h.shape
    proj = h @ w_in
    nq = RET_HEADS * RET_QK_DIM
    nv = RET_HEADS * RET_V_DIM
    q, k, v, g = jnp.split(proj, [nq, 2 * nq, 2 * nq + nv], axis=-1)

    def heads(a, d):
        return a.reshape(B, S, RET_HEADS, d).transpose(0, 2, 1, 3).astype(jnp.float32)

    q = heads(q, RET_QK_DIM)
    k = heads(k, RET_QK_DIM) * (RET_QK_DIM ** -0.5)
    v = heads(v, RET_V_DIM)
    fwd = retention_one_direction(q, k, v, log_decay_fwd, strict=False)
    bwd = jnp.flip(retention_one_direction(jnp.flip(q, 2), jnp.flip(k, 2), jnp.flip(v, 2), log_decay_bwd, strict=True), 2)
    o = fwd + bwd
    o = o * lax.rsqrt(jnp.mean(o * o, axis=-1, keepdims=True) + EPS)
    o = o.transpose(0, 2, 1, 3).reshape(B, S, nv).astype(h.dtype)
    return (jax.nn.silu(g) * o) @ w_out


def alibi_slopes(n_heads):
    return jnp.exp2(-8.0 * jnp.arange(1, n_heads + 1, dtype=jnp.float32) / n_heads)


def windowed_gqa_mixer(h, w_in, w_out, sink):
    B, S, _ = h.shape
    W = WINDOW
    nb = S // W
    proj = h @ w_in
    nq = ATT_Q_HEADS * ATT_HEAD_DIM
    nk = ATT_KV_HEADS * ATT_HEAD_DIM
    q, k, v = jnp.split(proj, [nq, nq + nk], axis=-1)
    q = q.reshape(B, nb, W, ATT_KV_HEADS, ATT_GROUP, ATT_HEAD_DIM)

    def band(a):
        a = a.reshape(B, S, ATT_KV_HEADS, ATT_HEAD_DIM)
        a = jnp.pad(a, ((0, 0), (W, W), (0, 0), (0, 0))).reshape(B, nb + 2, W, ATT_KV_HEADS, ATT_HEAD_DIM)
        return jnp.concatenate([a[:, :-2], a[:, 1:-1], a[:, 2:]], axis=2)

    kb, vb = band(k), band(v)
    scores = jnp.einsum('bnqhgd,bnkhd->bnhgqk', q, kb).astype(jnp.float32) * (ATT_HEAD_DIM ** -0.5)
    i = jnp.arange(W)[:, None]
    j = jnp.arange(3 * W)[None, :]
    dist = jnp.abs(W + i - j)
    kpos = (jnp.arange(nb)[:, None] - 1) * W + jnp.arange(3 * W)[None, :]
    valid = (dist <= W)[None] & ((kpos >= 0) & (kpos < S))[:, None, :]
    slopes = alibi_slopes(ATT_Q_HEADS).reshape(ATT_KV_HEADS, ATT_GROUP)
    bias = -slopes[:, :, None, None] * dist.astype(jnp.float32)[None, None]
    scores = jnp.where(valid[None, :, None, None], scores + bias[None, None], NEG_INF)
    sink_col = jnp.broadcast_to(sink.astype(jnp.float32).reshape(ATT_KV_HEADS, ATT_GROUP)[None, None, :, :, None, None],
                                scores.shape[:-1] + (1,))
    probs = jax.nn.softmax(jnp.concatenate([scores, sink_col], axis=-1), axis=-1)[..., :-1]
    out = jnp.einsum('bnhgqk,bnkhd->bnqhgd', probs.astype(vb.dtype), vb)
    return out.reshape(B, S, nq) @ w_out


def squared_relu_mlp(h, w_up, w_down):
    a = jax.nn.relu(h @ w_up)
    return (a * a) @ w_down


def setup_inputs(seed: int = 0) -> dict:
    key = jax.random.key(seed)
    ks = jax.random.split(key, 16)
    f32 = jnp.float32

    def w(k, shape, fan_in):
        return jax.random.normal(k, shape, f32) * (fan_in ** -0.5)

    def gain(k):
        return 1.0 + 0.05 * jax.random.normal(k, (DEPTH, D_MODEL), f32)

    base = jnp.log1p(-jnp.exp2(-5.0 - jnp.arange(RET_HEADS, dtype=f32)))
    return {
        "x": jax.random.normal(ks[0], (BATCH, SEQ, D_MODEL), f32),
        "w_in_ret": w(ks[1], (N_RET_LAYERS, D_MODEL, RET_IN), D_MODEL),
        "w_out_ret": w(ks[2], (N_RET_LAYERS, RET_HEADS * RET_V_DIM, D_MODEL), RET_HEADS * RET_V_DIM),
        "log_decay_fwd": base[None] * (1.0 + 0.05 * jax.random.normal(ks[3], (N_RET_LAYERS, RET_HEADS), f32)),
        "log_decay_bwd": base[None] * (1.0 + 0.05 * jax.random.normal(ks[4], (N_RET_LAYERS, RET_HEADS), f32)),
        "w_in_attn": w(ks[5], (N_ATT_LAYERS, D_MODEL, ATT_IN), D_MODEL),
        "w_out_attn": w(ks[6], (N_ATT_LAYERS, ATT_Q_HEADS * ATT_HEAD_DIM, D_MODEL), ATT_Q_HEADS * ATT_HEAD_DIM),
        "sink_logits": 0.5 * jax.random.normal(ks[7], (N_ATT_LAYERS, ATT_Q_HEADS), f32),
        "g_pre_mix": gain(ks[8]),
        "g_post_mix": gain(ks[9]),
        "g_pre_mlp": gain(ks[10]),
        "g_post_mlp": gain(ks[11]),
        "w_up": w(ks[12], (DEPTH, D_MODEL, D_FF), D_MODEL),
        "w_down": w(ks[13], (DEPTH, D_FF, D_MODEL), D_FF),
    }


def reference(x, w_in_ret, w_out_ret, log_decay_fwd, log_decay_bwd, w_in_attn, w_out_attn,
              sink_logits, g_pre_mix, g_post_mix, g_pre_mlp, g_post_mlp, w_up, w_down):
    for layer in range(DEPTH):
        h = rms_norm(x, g_pre_mix[layer])
        if layer % N_MIXERS == 0:
            r = layer // N_MIXERS
            h = retention_mixer(h, w_in_ret[r], w_out_ret[r], log_decay_fwd[r], log_decay_bwd[r])
        else:
            a = layer // N_MIXERS
            h = windowed_gqa_mixer(h, w_in_attn[a], w_out_attn[a], sink_logits[a])
        x = x + rms_norm(h, g_post_mix[layer])
        h = squared_relu_mlp(rms_norm(x, g_pre_mlp[layer]), w_up[layer], w_down[layer])
        x = x + rms_norm(h, g_post_mlp[layer])
    return x
```

```cpp
#include <hip/hip_runtime.h>
#include <hip/hip_cooperative_groups.h>
#include <stdint.h>
#include <stdio.h>
namespace cg = cooperative_groups;

typedef unsigned short bf16_t;
using bf16x8 = __attribute__((ext_vector_type(8))) short;
using f32x4  = __attribute__((ext_vector_type(4))) float;

constexpr int T_TOK = 16384, DM = 1024, SEQ = 2048;
constexpr float EPSV = 1e-6f;
constexpr float LOG2E = 1.4426950408889634f;

constexpr size_t OFF_BAR   = 0;
constexpr size_t OFF_WIN   = 65536;
constexpr size_t OFF_WOUT  = OFF_WIN  + 12582912;
constexpr size_t OFF_WUP   = OFF_WOUT + 4194304;
constexpr size_t OFF_WDN   = OFF_WUP  + 8388608;
constexpr size_t OFF_XB    = OFF_WDN  + 8388608;
constexpr size_t OFF_RSTD  = OFF_XB   + 33554432;
constexpr size_t OFF_OPART = OFF_RSTD + 65536;
constexpr size_t OFF_XFLAG = OFF_BAR + 16384;
constexpr size_t OFF_XCH   = OFF_OPART + 65536;
constexpr size_t OFF_XFLAG2 = OFF_BAR + 24576;
constexpr size_t OFF_XCH2  = OFF_OPART + 65536 + 131072;
constexpr size_t OFF_HB    = OFF_OPART + 4194304;
constexpr size_t OFF_M     = OFF_HB + 33554432;
constexpr size_t OFF_ABUF  = OFF_M;
constexpr size_t OFF_QQ    = OFF_ABUF + 67108864;
constexpr size_t OFF_KQ    = OFF_QQ  + 8388608;
constexpr size_t OFF_KFT   = OFF_KQ  + 8388608;
constexpr size_t OFF_KBT   = OFF_KFT + 8388608;
constexpr size_t OFF_VT    = OFF_KBT + 8388608;
constexpr size_t OFF_RQ    = OFF_VT  + 16777216;
constexpr size_t OFF_PQ    = OFF_RQ  + 29360128;
constexpr size_t OFF_END_R = OFF_PQ  + 8388608;
constexpr size_t OFF_AQ    = OFF_M;
constexpr size_t OFF_AK    = OFF_AQ + 33554432;
constexpr size_t OFF_AVT   = OFF_AK + 8388608;
constexpr size_t OFF_AO    = OFF_AVT + 8388608;
constexpr size_t OFF_HID   = OFF_M;
constexpr size_t WS_NEED   = OFF_END_R;
__device__ __forceinline__ size_t off_qq(int par) { return par ? OFF_HB : OFF_QQ; }
__device__ __forceinline__ size_t off_vt(int par) { return par ? OFF_HB + 8388608 : OFF_VT; }

constexpr int LDS_STAGE = 131072;
constexpr int LDS_BYTES = LDS_STAGE + 64;

struct Params {
  const float *x, *w_in_ret, *w_out_ret, *ldf, *ldb, *w_in_attn, *w_out_attn, *sink;
  const float *g_pre_mix, *g_post_mix, *g_pre_mlp, *g_post_mlp, *w_up, *w_down;
  float* out;
  unsigned char* ws;
};

__device__ __forceinline__ float bf2f(unsigned v) { return __uint_as_float(v << 16); }
__device__ __forceinline__ unsigned f2bf(float f) { unsigned u = __float_as_uint(f); u += 0x7fffu + ((u >> 16) & 1u); return u >> 16; }
typedef float f32x2_t __attribute__((ext_vector_type(2)));
typedef __bf16 bf16x2_t __attribute__((ext_vector_type(2)));
__device__ __forceinline__ unsigned pack2(float a, float b) { f32x2_t v = {a, b}; return __builtin_bit_cast(unsigned, __builtin_convertvector(v, bf16x2_t)); }
__device__ __forceinline__ int opaque_tid() { int t = (int)threadIdx.x; asm volatile("" : "+v"(t)); return t; }
__device__ __forceinline__ unsigned char* opaque_ptr(unsigned char* p) { size_t z = 0; asm volatile("" : "+s"(z)); return p + z; }
__device__ __forceinline__ float wave_sum(float v) {
#pragma unroll
  for (int o = 32; o >= 1; o >>= 1) v += __shfl_xor(v, o);
  return v;
}

#define XB_TMO      128
#define XB_XCNT(j)  (256  + 64 * (j))
#define XB_XSUB(j)  (1280 + 64 * (j))
#define XB_XGEN(j)  (2304 + 64 * (j))
#define XB_TOP      3328
#define XB_TOPGEN   3392
#define XCD_BAR_WORDS 3456
#define XB_SPIN_CAP (1u << 22)
#define LAS __attribute__((address_space(3)))

__device__ __forceinline__ unsigned xb_ld(unsigned* p)              { return __hip_atomic_load(p, __ATOMIC_RELAXED, __HIP_MEMORY_SCOPE_AGENT); }
__device__ __forceinline__ unsigned xb_add(unsigned* p, unsigned v) { return __hip_atomic_fetch_add(p, v, __ATOMIC_RELAXED, __HIP_MEMORY_SCOPE_AGENT); }
__device__ __forceinline__ unsigned xb_xcc_id() { return (unsigned)__builtin_amdgcn_s_getreg((3 << 11) | 20) & 0xFu; }
#define XB_SPIN(cond, bar) do { unsigned _sp = 0; while (cond) { __builtin_amdgcn_s_sleep(1); \
    if ((++_sp & 255u) == 0u) { if (xb_ld(&(bar)[XB_TMO])) break; if (_sp > XB_SPIN_CAP) { atomicAdd(&(bar)[XB_TMO], 1u); break; } } } } while (0)

struct XcdBarrier { unsigned* bar; unsigned x; volatile LAS unsigned* st; };

__device__ __forceinline__ XcdBarrier xcd_barrier_post(unsigned* bar, volatile LAS unsigned* st) {
  XcdBarrier b; b.bar = bar; b.x = xb_xcc_id(); b.st = st;
  if (threadIdx.x == 0) (void)xb_add(&bar[XB_XCNT(b.x)], 1u);
  return b;
}
__device__ __forceinline__ void xcd_barrier_complete(unsigned* bar, unsigned x, unsigned& nloc, unsigned& nx) {
  const unsigned G = gridDim.x * gridDim.y * gridDim.z;
  unsigned sum, cnt, mine, sp = 0u;
  for (;;) {
    sum = 0u; cnt = 0u; mine = 0u;
#pragma unroll
    for (unsigned j = 0; j < 16; ++j) { const unsigned c = xb_ld(&bar[XB_XCNT(j)]); sum += c; cnt += (c > 0u) ? 1u : 0u; mine = (j == x) ? c : mine; }
    if (sum == G) break;
    __builtin_amdgcn_s_sleep(1);
    if ((++sp & 255u) == 0u) { if (xb_ld(&bar[XB_TMO])) break; if (sp > XB_SPIN_CAP) { atomicAdd(&bar[XB_TMO], 1u); break; } }
  }
  nloc = mine > 0u ? mine : 1u; nx = cnt > 0u ? cnt : 1u;
}
__device__ __forceinline__ void xcd_barrier(const XcdBarrier& b) {
  asm volatile("s_waitcnt vmcnt(0)" ::: "memory");
  __syncthreads();
  if (threadIdx.x == 0) {
    unsigned* bar = b.bar;
    __builtin_amdgcn_s_waitcnt(0);
    unsigned nloc = b.st[0], nx = b.st[1];
    if (nloc == 0u) { xcd_barrier_complete(bar, b.x, nloc, nx); b.st[0] = nloc; b.st[1] = nx; }
    const unsigned old = xb_add(&bar[XB_XSUB(b.x)], 1u);
    const unsigned gen = old / nloc;
    if (old + 1u == (gen + 1u) * nloc) {
      __builtin_amdgcn_fence(__ATOMIC_RELEASE, "agent");
      asm volatile("s_waitcnt vmcnt(0)" ::: "memory");
      const unsigned og = xb_add(&bar[XB_TOP], 1u);
      const unsigned tg = og / nx;
      if (og + 1u == (tg + 1u) * nx) xb_add(&bar[XB_TOPGEN], 1u);
      else XB_SPIN(xb_ld(&bar[XB_TOPGEN]) == tg, bar);
      __builtin_amdgcn_fence(__ATOMIC_ACQUIRE, "agent");
      xb_add(&bar[XB_XGEN(b.x)], 1u);
      asm volatile("s_waitcnt vmcnt(0)" ::: "memory");
    } else {
      XB_SPIN(xb_ld(&bar[XB_XGEN(b.x)]) == gen, bar);
      __builtin_amdgcn_fence(__ATOMIC_ACQUIRE, "agent");
      asm volatile("s_waitcnt vmcnt(0)" ::: "memory");
    }
  }
  __syncthreads();
}

template <bool SWAP>
__device__ __forceinline__ void gemm_acc(f32x4 (&acc)[4][4], const bf16_t* __restrict__ A, int lda,
                                         const bf16_t* __restrict__ B, int ldb, int K, char* lds, const int tid) {
  const int lane = tid & 63, wid = tid >> 6;
  const int wm = wid >> 1, wn = wid & 1;
  const int r = lane & 15, quad = lane >> 4;
  const int lrow = tid >> 3, lkc = tid & 7;
  const bf16_t* Ag = A + (size_t)lrow * lda + lkc * 8;
  const bf16_t* Bg = B + (size_t)lrow * ldb + lkc * 8;
  const int wofs = lrow * 128 + ((lkc ^ (lrow & 7)) << 4);
  const int aofs = (wm * 64 + r) * 128;
  const int bofs = 16384 + (wn * 64 + r) * 128;
  const int sw = r & 7;
  uint4 ra0, ra1, ra2, ra3, rb0, rb1, rb2, rb3;
  const int nk = K >> 6;
#define G_LOAD(k0) do { \
    ra0 = *reinterpret_cast<const uint4*>(Ag + (k0));                       rb0 = *reinterpret_cast<const uint4*>(Bg + (k0)); \
    ra1 = *reinterpret_cast<const uint4*>(Ag + (size_t)32 * lda + (k0));    rb1 = *reinterpret_cast<const uint4*>(Bg + (size_t)32 * ldb + (k0)); \
    ra2 = *reinterpret_cast<const uint4*>(Ag + (size_t)64 * lda + (k0));    rb2 = *reinterpret_cast<const uint4*>(Bg + (size_t)64 * ldb + (k0)); \
    ra3 = *reinterpret_cast<const uint4*>(Ag + (size_t)96 * lda + (k0));    rb3 = *reinterpret_cast<const uint4*>(Bg + (size_t)96 * ldb + (k0)); } while (0)
#define G_STORE(buf) do { char* _d = (buf) + wofs; \
    *reinterpret_cast<uint4*>(_d) = ra0;          *reinterpret_cast<uint4*>(_d + 16384) = rb0; \
    *reinterpret_cast<uint4*>(_d + 4096) = ra1;   *reinterpret_cast<uint4*>(_d + 16384 + 4096) = rb1; \
    *reinterpret_cast<uint4*>(_d + 8192) = ra2;   *reinterpret_cast<uint4*>(_d + 16384 + 8192) = rb2; \
    *reinterpret_cast<uint4*>(_d + 12288) = ra3;  *reinterpret_cast<uint4*>(_d + 16384 + 12288) = rb3; } while (0)
#define G_COMPUTE(cur) do { \
    _Pragma("unroll") for (int ks = 0; ks < 2; ++ks) { \
      bf16x8 af0, af1, af2, af3, bf0, bf1, bf2, bf3; \
      const int co = ((ks * 4 + quad) ^ sw) << 4; \
      af0 = *reinterpret_cast<const bf16x8*>((cur) + aofs + co);        bf0 = *reinterpret_cast<const bf16x8*>((cur) + bofs + co); \
      af1 = *reinterpret_cast<const bf16x8*>((cur) + aofs + 2048 + co); bf1 = *reinterpret_cast<const bf16x8*>((cur) + bofs + 2048 + co); \
      af2 = *reinterpret_cast<const bf16x8*>((cur) + aofs + 4096 + co); bf2 = *reinterpret_cast<const bf16x8*>((cur) + bofs + 4096 + co); \
      af3 = *reinterpret_cast<const bf16x8*>((cur) + aofs + 6144 + co); bf3 = *reinterpret_cast<const bf16x8*>((cur) + bofs + 6144 + co); \
      G_MMA(0, 0, af0, bf0); G_MMA(0, 1, af0, bf1); G_MMA(0, 2, af0, bf2); G_MMA(0, 3, af0, bf3); \
      G_MMA(1, 0, af1, bf0); G_MMA(1, 1, af1, bf1); G_MMA(1, 2, af1, bf2); G_MMA(1, 3, af1, bf3); \
      G_MMA(2, 0, af2, bf0); G_MMA(2, 1, af2, bf1); G_MMA(2, 2, af2, bf2); G_MMA(2, 3, af2, bf3); \
      G_MMA(3, 0, af3, bf0); G_MMA(3, 1, af3, bf1); G_MMA(3, 2, af3, bf2); G_MMA(3, 3, af3, bf3); \
    } } while (0)
#define G_MMA(ms, ns, a, b) acc[ms][ns] = SWAP ? __builtin_amdgcn_mfma_f32_16x16x32_bf16(b, a, acc[ms][ns], 0, 0, 0) \
                                               : __builtin_amdgcn_mfma_f32_16x16x32_bf16(a, b, acc[ms][ns], 0, 0, 0)
  G_LOAD(0);
  __syncthreads();
  G_STORE(lds);
  __syncthreads();
  for (int kt = 0; kt < nk - 1; ++kt) {
    char* cur = lds + (kt & 1) * 32768;
    char* nxt = lds + ((kt + 1) & 1) * 32768;
    const int k0 = (kt + 1) * 64;
    G_LOAD(k0);
    G_COMPUTE(cur);
    G_STORE(nxt);
    __syncthreads();
  }
  {
    char* cur = lds + ((nk - 1) & 1) * 32768;
    G_COMPUTE(cur);
    __syncthreads();
  }
#undef G_LOAD
#undef G_STORE
#undef G_COMPUTE
#undef G_MMA
}


__device__ __forceinline__ void store_tile_plain(const f32x4 (&acc)[4][4], bf16_t* dst, int ld, const int tid) {
  const int lane = tid & 63, wid = tid >> 6, wm = wid >> 1, wn = wid & 1, r = lane & 15, quad = lane >> 4;
#pragma unroll
  for (int ms = 0; ms < 4; ++ms) {
    const int m = wm * 64 + ms * 16 + r;
#pragma unroll
    for (int ns = 0; ns < 4; ++ns) {
      const int n0 = wn * 64 + ns * 16 + quad * 4;
      const f32x4 v = acc[ms][ns];
      uint2 o; o.x = pack2(v[0], v[1]); o.y = pack2(v[2], v[3]);
      *reinterpret_cast<uint2*>(dst + (size_t)m * ld + n0) = o;
    }
  }
}

__device__ __forceinline__ void store_tile8(const f32x4 (&acc)[4][2], bf16_t* dst, int ld, const int tid) {
  const int lane = tid & 63, wid = tid >> 6, wm = wid >> 2, wn = wid & 3, r = lane & 15, quad = lane >> 4;
#pragma unroll
  for (int ms = 0; ms < 4; ++ms) {
    const int m = wm * 64 + ms * 16 + r;
#pragma unroll
    for (int ns = 0; ns < 2; ++ns) {
      const int n0 = wn * 32 + ns * 16 + quad * 4;
      const f32x4 v = acc[ms][ns];
      uint2 o; o.x = pack2(v[0], v[1]); o.y = pack2(v[2], v[3]);
      *reinterpret_cast<uint2*>(dst + (size_t)m * ld + n0) = o;
    }
  }
}
template <int MODE>
__device__ __forceinline__ void gm_ptrs(int g, const bf16_t* P0, const bf16_t* P1, const bf16_t* P2, const bf16_t* P3, const bf16_t* P4, int i0,
                                        const bf16_t*& A, int& lda, const bf16_t*& B, int& ldb) {
  if (MODE == 2) {
    A = P0 + g * 64; B = P1 + g * 64; lda = i0 & 0xffff; ldb = i0 >> 16;
  } else if (MODE == 0) {
    const int s = g >> 2, c = i0 ? 7 - s : s, ko = c * 256 + (g & 3) * 64;
    A = P0 + c * 32768 + (g & 3) * 64; B = P1 + c * 32768 + (g & 3) * 64; lda = 256; ldb = 256;
  } else {
    const int s = g >> 2, ty = (i0 == 0) ? s + 1 : ((i0 == 7) ? (s == 0 ? 0 : 2) : s), ko = (g & 3) * 64;
    const bool pv = (ty == 2);
    A = (pv ? P3 : P0) + ko; lda = pv ? 256 : 1024;
    const bf16_t* bsel = (ty == 0) ? P1 : P2;
    B = (pv ? P4 : bsel) + ko; ldb = 256;
  }
}
template <int MODE>
__device__ __forceinline__ void gemm8(f32x4 (&acc)[4][2], const int nsteps, const bf16_t* P0, const bf16_t* P1, const bf16_t* P2, const bf16_t* P3,
                                      const bf16_t* P4, const int i0, const float s0, const float s1, const float s2, const float s3,
                                      const float s4, const float s5, const float s6, const float s7, char* lds, const int tid) {
  const int lane = tid & 63, wid = tid >> 6;
  const int wm = wid >> 2, wn = wid & 3;
  const int r = lane & 15, quad = lane >> 4;
  const int lrow = tid >> 3, lkc = tid & 7;
  const int wofs = lrow * 128 + ((lkc ^ (lrow & 7)) << 4);
  const int aofs = (wm * 64 + r) * 128;
  const int bofs = 16384 + (wn * 32 + r) * 128;
  const int sw = r & 7;
  uint4 xa0, xa1, xb0, xb1, ya0, ya1, yb0, yb1, za0, za1, zb0, zb1, wa0, wa1, wb0, wb1;
#define GM_LOAD(g, S) do { const bf16_t* _Ap; const bf16_t* _Bp; int _lda, _ldb; gm_ptrs<MODE>((g), P0, P1, P2, P3, P4, i0, _Ap, _lda, _Bp, _ldb); \
    const bf16_t* _a = _Ap + (size_t)lrow * _lda + lkc * 8; const bf16_t* _b = _Bp + (size_t)lrow * _ldb + lkc * 8; \
    S##a0 = *reinterpret_cast<const uint4*>(_a);                       S##b0 = *reinterpret_cast<const uint4*>(_b); \
    S##a1 = *reinterpret_cast<const uint4*>(_a + (size_t)64 * _lda);   S##b1 = *reinterpret_cast<const uint4*>(_b + (size_t)64 * _ldb); } while (0)
#define GM_STORE(buf, S) do { char* _d = (buf) + wofs; \
    *reinterpret_cast<uint4*>(_d) = S##a0;          *reinterpret_cast<uint4*>(_d + 16384) = S##b0; \
    *reinterpret_cast<uint4*>(_d + 8192) = S##a1;   *reinterpret_cast<uint4*>(_d + 16384 + 8192) = S##b1; } while (0)
#define GM_MMA(ms, ns, a, b) acc[ms][ns] = __builtin_amdgcn_mfma_f32_16x16x32_bf16(b, a, acc[ms][ns], 0, 0, 0)
#define GM_COMPUTE(cur) do { \
    bf16x8 a00, a01, a02, a03, b00, b01, a10, a11, a12, a13, b10, b11; \
    const int co0 = ((0 + quad) ^ sw) << 4, co1 = ((4 + quad) ^ sw) << 4; \
    a00 = *reinterpret_cast<const bf16x8*>((cur) + aofs + co0);        b00 = *reinterpret_cast<const bf16x8*>((cur) + bofs + co0); \
    a01 = *reinterpret_cast<const bf16x8*>((cur) + aofs + 2048 + co0); b01 = *reinterpret_cast<const bf16x8*>((cur) + bofs + 2048 + co0); \
    a02 = *reinterpret_cast<const bf16x8*>((cur) + aofs + 4096 + co0); \
    a03 = *reinterpret_cast<const bf16x8*>((cur) + aofs + 6144 + co0); \
    a10 = *reinterpret_cast<const bf16x8*>((cur) + aofs + co1);        b10 = *reinterpret_cast<const bf16x8*>((cur) + bofs + co1); \
    a11 = *reinterpret_cast<const bf16x8*>((cur) + aofs + 2048 + co1); b11 = *reinterpret_cast<const bf16x8*>((cur) + bofs + 2048 + co1); \
    a12 = *reinterpret_cast<const bf16x8*>((cur) + aofs + 4096 + co1); \
    a13 = *reinterpret_cast<const bf16x8*>((cur) + aofs + 6144 + co1); \
    __builtin_amdgcn_sched_barrier(0); \
    GM_MMA(0, 0, a00, b00); GM_MMA(0, 1, a00, b01); GM_MMA(1, 0, a01, b00); GM_MMA(1, 1, a01, b01); \
    GM_MMA(2, 0, a02, b00); GM_MMA(2, 1, a02, b01); GM_MMA(3, 0, a03, b00); GM_MMA(3, 1, a03, b01); \
    GM_MMA(0, 0, a10, b10); GM_MMA(0, 1, a10, b11); GM_MMA(1, 0, a11, b10); GM_MMA(1, 1, a11, b11); \
    GM_MMA(2, 0, a12, b10); GM_MMA(2, 1, a12, b11); GM_MMA(3, 0, a13, b10); GM_MMA(3, 1, a13, b11); \
    __builtin_amdgcn_sched_barrier(0); \
  } while (0)
#define GM_PRE(g) do { if (MODE == 0 && ((g) & 3) == 0 && (g) > 0) { \
      _Pragma("unroll") for (int ms = 0; ms < 4; ++ms) _Pragma("unroll") for (int ns = 0; ns < 2; ++ns) acc[ms][ns] *= s0; } } while (0)
#define GM_POST(g) do { if (((g) & 3) == 3) { \
      if (MODE == 0) { const int _s = (g) >> 2, _c = i0 ? 7 - _s : _s, _slot = i0 ? _c - 1 : _c; \
        store_tile8(acc, const_cast<bf16_t*>(P2) + (size_t)_slot * 512 * 256, 256, tid); } \
      else if (MODE == 1) { const int _s = (g) >> 2, _ty = (i0 == 0) ? _s + 1 : ((i0 == 7) ? (_s == 0 ? 0 : 2) : _s); \
        if (_ty == 0) { _Pragma("unroll") for (int ns = 0; ns < 2; ++ns) { acc[0][ns] *= s0; acc[1][ns] *= s1; acc[2][ns] *= s2; acc[3][ns] *= s3; } } \
        else if (_ty == 1) { _Pragma("unroll") for (int ns = 0; ns < 2; ++ns) { acc[0][ns] *= s4; acc[1][ns] *= s5; acc[2][ns] *= s6; acc[3][ns] *= s7; } } } } } while (0)
  char* b0 = lds;
  char* b1 = lds + 32768;
  GM_LOAD(0, x); GM_LOAD(1, y); GM_LOAD(2, z); GM_LOAD(3, w);
  __syncthreads();
  GM_STORE(b0, x);
  __syncthreads();
  for (int g = 0; g < nsteps; g += 4) {
    const bool more = (g + 4 < nsteps);
    if (more) GM_LOAD(g + 4, x);
    GM_PRE(g);     GM_COMPUTE(b0); GM_POST(g);     GM_STORE(b1, y); __syncthreads();
    if (more) GM_LOAD(g + 5, y);
    GM_PRE(g + 1); GM_COMPUTE(b1); GM_POST(g + 1); GM_STORE(b0, z); __syncthreads();
    if (more) GM_LOAD(g + 6, z);
    GM_PRE(g + 2); GM_COMPUTE(b0); GM_POST(g + 2); GM_STORE(b1, w); __syncthreads();
    if (more) GM_LOAD(g + 7, w);
    GM_PRE(g + 3); GM_COMPUTE(b1); GM_POST(g + 3); if (more) GM_STORE(b0, x); __syncthreads();
  }
#undef GM_PRE
#undef GM_POST
#undef GM_LOAD
#undef GM_STORE
#undef GM_COMPUTE
#undef GM_MMA
}

__device__ __forceinline__ void gemm8w(f32x4 (&acc)[4][4], const int nsteps, const bf16_t* Aq, const bf16_t* Rf, const bf16_t* Rb, const bf16_t* Pp,
                                       const bf16_t* V0, const bf16_t* V1, const int c, const float s0, const float s1, const float s2, const float s3,
                                       const float s4, const float s5, const float s6, const float s7, char* lds, const int tid) {
  const int lane = tid & 63, wid = tid >> 6;
  const int wm = wid >> 2, wn = wid & 3;
  const int r = lane & 15, quad = lane >> 4;
  const int lrow = tid >> 3, lkc = tid & 7;
  const int wofs = lrow * 128 + ((lkc ^ (lrow & 7)) << 4);
  const int aofs = (wm * 64 + r) * 128;
  const int bofs = 16384 + (wn * 64 + r) * 128;
  const int sw = r & 7;
  uint4 xa0, xa1, xb0, xb1, xb2, xb3, ya0, ya1, yb0, yb1, yb2, yb3;
#define GW_TYPE(g) ((c == 0) ? ((g) >> 2) + 1 : ((c == 7) ? ((((g) >> 2) == 0) ? 0 : 2) : ((g) >> 2)))
#define GW_LOAD(g, S) do { const int _ty = GW_TYPE(g), _ko = ((g) & 3) * 64; const bool _pv = (_ty == 2); \
    const bf16_t* _a = (_pv ? Pp : Aq) + (size_t)lrow * (_pv ? 256 : 1024) + lkc * 8 + _ko; const size_t _a64 = (size_t)64 * (_pv ? 256 : 1024); \
    const bf16_t* _bs = (_ty == 0) ? Rf : Rb; \
    const bf16_t* _lo = (_pv ? V0 : _bs) + (size_t)lrow * 256 + lkc * 8 + _ko; \
    const bf16_t* _hi = (_pv ? V1 : _bs + 128 * 256) + (size_t)lrow * 256 + lkc * 8 + _ko; \
    S##a0 = *reinterpret_cast<const uint4*>(_a);        S##a1 = *reinterpret_cast<const uint4*>(_a + _a64); \
    S##b0 = *reinterpret_cast<const uint4*>(_lo);       S##b1 = *reinterpret_cast<const uint4*>(_lo + 64 * 256); \
    S##b2 = *reinterpret_cast<const uint4*>(_hi);       S##b3 = *reinterpret_cast<const uint4*>(_hi + 64 * 256); } while (0)
#define GW_STORE(buf, S) do { char* _d = (buf) + wofs; \
    *reinterpret_cast<uint4*>(_d) = S##a0;                  *reinterpret_cast<uint4*>(_d + 8192) = S##a1; \
    *reinterpret_cast<uint4*>(_d + 16384) = S##b0;          *reinterpret_cast<uint4*>(_d + 16384 + 8192) = S##b1; \
    *reinterpret_cast<uint4*>(_d + 16384 + 16384) = S##b2;  *reinterpret_cast<uint4*>(_d + 16384 + 24576) = S##b3; } while (0)
#define GW_MMA(ms, ns, a, b) acc[ms][ns] = __builtin_amdgcn_mfma_f32_16x16x32_bf16(b, a, acc[ms][ns], 0, 0, 0)
#define GW_COMPUTE(cur) do { \
    _Pragma("unroll") for (int ks = 0; ks < 2; ++ks) { \
      bf16x8 af0, af1, af2, af3, bf0, bf1, bf2, bf3; \
      const int co = ((ks * 4 + quad) ^ sw) << 4; \
      af0 = *reinterpret_cast<const bf16x8*>((cur) + aofs + co);        bf0 = *reinterpret_cast<const bf16x8*>((cur) + bofs + co); \
      af1 = *reinterpret_cast<const bf16x8*>((cur) + aofs + 2048 + co); bf1 = *reinterpret_cast<const bf16x8*>((cur) + bofs + 2048 + co); \
      af2 = *reinterpret_cast<const bf16x8*>((cur) + aofs + 4096 + co); bf2 = *reinterpret_cast<const bf16x8*>((cur) + bofs + 4096 + co); \
      af3 = *reinterpret_cast<const bf16x8*>((cur) + aofs + 6144 + co); bf3 = *reinterpret_cast<const bf16x8*>((cur) + bofs + 6144 + co); \
      __builtin_amdgcn_sched_barrier(0); \
      GW_MMA(0, 0, af0, bf0); GW_MMA(0, 1, af0, bf1); GW_MMA(0, 2, af0, bf2); GW_MMA(0, 3, af0, bf3); \
      GW_MMA(1, 0, af1, bf0); GW_MMA(1, 1, af1, bf1); GW_MMA(1, 2, af1, bf2); GW_MMA(1, 3, af1, bf3); \
      GW_MMA(2, 0, af2, bf0); GW_MMA(2, 1, af2, bf1); GW_MMA(2, 2, af2, bf2); GW_MMA(2, 3, af2, bf3); \
      GW_MMA(3, 0, af3, bf0); GW_MMA(3, 1, af3, bf1); GW_MMA(3, 2, af3, bf2); GW_MMA(3, 3, af3, bf3); \
      __builtin_amdgcn_sched_barrier(0); \
    } } while (0)
#define GW_POST(g) do { if (((g) & 3) == 3) { const int _ty = GW_TYPE(g); \
      if (_ty == 0) { _Pragma("unroll") for (int ns = 0; ns < 4; ++ns) { acc[0][ns] *= s0; acc[1][ns] *= s1; acc[2][ns] *= s2; acc[3][ns] *= s3; } } \
      else if (_ty == 1) { _Pragma("unroll") for (int ns = 0; ns < 4; ++ns) { acc[0][ns] *= s4; acc[1][ns] *= s5; acc[2][ns] *= s6; acc[3][ns] *= s7; } } } } while (0)
  char* b0 = lds;
  char* b1 = lds + 49152;
  GW_LOAD(0, x); GW_LOAD(1, y);
  __syncthreads();
  GW_STORE(b0, x);
  __syncthreads();
  for (int g = 0; g < nsteps; g += 2) {
    const bool more = (g + 2 < nsteps);
    if (more) GW_LOAD(g + 2, x);
    GW_COMPUTE(b0); GW_POST(g);     GW_STORE(b1, y); __syncthreads();
    if (more) GW_LOAD(g + 3, y);
    GW_COMPUTE(b1); GW_POST(g + 1); if (more) GW_STORE(b0, x); __syncthreads();
  }
#undef GW_TYPE
#undef GW_LOAD
#undef GW_STORE
#undef GW_MMA
#undef GW_COMPUTE
#undef GW_POST
}

__device__ __forceinline__ void zero_acc(f32x4 (&acc)[4][4]) {
#pragma unroll
  for (int ms = 0; ms < 4; ++ms)
#pragma unroll
    for (int ns = 0; ns < 4; ++ns) acc[ms][ns] = f32x4{0.f, 0.f, 0.f, 0.f};
}

__device__ __forceinline__ void store_tile_swap(const f32x4 (&acc)[4][4], bf16_t* dst, int ld, const float (&rs)[4], const int tid) {
  const int lane = tid & 63, wid = tid >> 6, wm = wid >> 1, wn = wid & 1, r = lane & 15, quad = lane >> 4;
#pragma unroll
  for (int ms = 0; ms < 4; ++ms) {
    const int m = wm * 64 + ms * 16 + r;
#pragma unroll
    for (int ns = 0; ns < 4; ++ns) {
      const int n0 = wn * 64 + ns * 16 + quad * 4;
      const f32x4 v = acc[ms][ns];
      uint2 o; o.x = pack2(v[0] * rs[ms], v[1] * rs[ms]); o.y = pack2(v[2] * rs[ms], v[3] * rs[ms]);
      *reinterpret_cast<uint2*>(dst + (size_t)m * ld + n0) = o;
    }
  }
}


namespace pg8 {
#define PG8_LAS __attribute__((address_space(3)))
typedef unsigned u32x4 __attribute__((ext_vector_type(4)));
constexpr int BM = 256, BK = 64, HALF = 128, HTB = HALF * BK * 2, NXCD = 8, WGM = 8;
__device__ __forceinline__ int lds_byte(int r, int c) { const int st = (r >> 4) * 2 + (c >> 5), rr = r & 15, cc = c & 31, ob = rr * 64 + cc * 2; return st * 1024 + (ob ^ (((ob >> 9) & 1) << 5)); }
__device__ __forceinline__ void stage_rc(int b, int& R, int& C) { const int st = b / 1024, sb = b % 1024, swz = sb ^ (((sb >> 9) & 1) << 5); R = (st >> 1) * 16 + swz / 64; C = (st & 1) * 32 + (swz % 64) / 2; }
__device__ __forceinline__ int perm32(int rho) { const int n = rho >> 4, i = rho & 15; return 8 * (i >> 2) + 4 * n + (i & 3); }
struct Unit { int pm, pn, kind; };
__device__ __forceinline__ unsigned cvt_pk_bf16(float lo, float hi) { unsigned r; asm volatile("s_nop 1\n\tv_cvt_pk_bf16_f32 %0, %1, %2" : "=v"(r) : "v"(lo), "v"(hi)); return r; }

__device__ __forceinline__ void decode_tile(int wgid, int nM, int nN, int& pm, int& pn) {
  const int nwg = nM * nN;
  { const int q = nwg / NXCD, r = nwg % NXCD, xcd = wgid % NXCD, off = wgid / NXCD; wgid = (xcd < r ? xcd * (q + 1) : r * (q + 1) + (xcd - r) * q) + off; }
  const int nig = WGM * nN, gid = wgid / nig, fm = gid * WGM, gsz = (nM - fm) < WGM ? (nM - fm) : WGM;
  pm = fm + ((wgid % nig) % gsz); pn = (wgid % nig) / gsz;
}
struct Sched2 {
  const char *A0, *B0, *A1, *B1; int nM0, nN0, nM1, nN1, G, c; size_t tstep;
  __device__ __forceinline__ bool next(int i, Unit& u) const {
    int L = i * G + c; const int n0 = nM0 * nN0, n1 = nM1 * nN1;
    if (L < n0) { u.kind = 0; decode_tile(L, nM0, nN0, u.pm, u.pn); return true; }
    L -= n0;
    if (L < n1) { u.kind = 1; decode_tile(L, nM1, nN1, u.pm, u.pn); return true; }
    return false;
  }
  __device__ __forceinline__ const char* aptr(const Unit& u) const { return (u.kind ? A1 : A0) + (size_t)u.pm * tstep; }
  __device__ __forceinline__ const char* bptr(const Unit& u) const { return (u.kind ? B1 : B0) + (size_t)u.pn * tstep; }
};

template <class Epi, class Sched>
__device__ __forceinline__ void gemm_phase(PG8_LAS unsigned char* lds, const int K, const Sched& S, const Epi& E) {
    const int tid = opaque_tid(), wid = __builtin_amdgcn_readfirstlane(tid >> 6), lane = tid & 63, wr = wid >> 2, wc = wid & 3, fr = lane & 15, fq = lane >> 4;
    const int nt = K / BK;
    unsigned voffA[2], voffB[2];
#pragma unroll
    for (int i = 0; i < 2; ++i) { int R, C; stage_rc(tid * 16 + i * 8192, R, C); const int Rb = ((R & ~31) + perm32(R & 31));
        voffA[i] = (unsigned)(R * K + C) * 2u; voffB[i] = (unsigned)(Rb * K + C) * 2u; }
    const size_t kstep = (size_t)(BK * 2);
    const size_t hstep = (size_t)HALF * K * 2;
    const unsigned ldsw = (unsigned)wid * 1024u;
    const int aoff = lds_byte(wr * 64 + fr, fq * 8), boff = lds_byte(wc * 32 + fr, fq * 8);
#define PG8_SA(b, h) (((b) * 2 + (h)) * HTB)
#define PG8_SB(b, h) ((4 + (b) * 2 + (h)) * HTB)
#define PG8_STAGE(bufoff, gbase, voff) do { _Pragma("unroll") for (int _i = 0; _i < 2; ++_i) \
        __builtin_amdgcn_global_load_lds((const unsigned*)((const char*)(gbase) + (voff)[_i]), (PG8_LAS unsigned*)(lds + (bufoff) + ldsw + _i * 8192), 16, 0, 0); } while (0)
#define PG8_LDA(dst, b, h) do { _Pragma("unroll") for (int m = 0; m < 4; ++m) _Pragma("unroll") for (int k = 0; k < 2; ++k) dst[m][k] = *(const PG8_LAS bf16x8*)(lds + PG8_SA(b, h) + aoff + m * 2048 + k * 1024); } while (0)
#define PG8_LDB(dst, b, h) do { _Pragma("unroll") for (int n = 0; n < 2; ++n) _Pragma("unroll") for (int k = 0; k < 2; ++k) dst[n][k] = *(const PG8_LAS bf16x8*)(lds + PG8_SB(b, h) + boff + n * 2048 + k * 1024); } while (0)
#define PG8_MMA(ai, bj, At, Bt) do { __builtin_amdgcn_s_setprio(1); _Pragma("unroll") for (int m = 0; m < 4; ++m) _Pragma("unroll") for (int n = 0; n < 2; ++n) _Pragma("unroll") for (int k = 0; k < 2; ++k) \
        acc[ai][bj][m][n] = __builtin_amdgcn_mfma_f32_16x16x32_bf16(Bt[n][k], At[m][k], acc[ai][bj][m][n], 0, 0, 0); __builtin_amdgcn_s_setprio(0); } while (0)
#define PG8_WAIT_V(n) asm volatile("s_waitcnt vmcnt(" #n ")" ::: "memory")
#define PG8_WAIT_L(n) asm volatile("s_waitcnt lgkmcnt(" #n ")" ::: "memory")
#define PG8_BAR __builtin_amdgcn_s_barrier()
#define PG8_SCHED __builtin_amdgcn_sched_barrier(0)
    Unit cur, nxt; int ui = 0;
    if (!S.next(0, cur)) return;
    f32x4 acc[2][2][4][2];
#pragma unroll
    for (int a = 0; a < 2; ++a)
#pragma unroll
        for (int b = 0; b < 2; ++b)
#pragma unroll
            for (int m = 0; m < 4; ++m)
#pragma unroll
                for (int n = 0; n < 2; ++n) acc[a][b][m][n] = (f32x4){0.f, 0.f, 0.f, 0.f};
    bf16x8 At[4][2], B0[2][2], B1[2][2];
    const char* cA = S.aptr(cur); const char* cB = S.bptr(cur);
    PG8_STAGE(PG8_SB(0, 0), cB, voffB); PG8_STAGE(PG8_SA(0, 0), cA, voffA); PG8_STAGE(PG8_SB(0, 1), cB + hstep, voffB); PG8_STAGE(PG8_SA(0, 1), cA + hstep, voffA);
    if (wr == 1) PG8_BAR;
    PG8_WAIT_V(4); PG8_BAR;
    PG8_STAGE(PG8_SB(1, 0), cB + kstep, voffB); PG8_STAGE(PG8_SA(1, 0), cA + kstep, voffA); PG8_STAGE(PG8_SB(1, 1), cB + hstep + kstep, voffB);
    PG8_WAIT_V(6); PG8_BAR;
    for (;;) {
        const bool has_next = S.next(ui + 1, nxt);
        const char* nA = has_next ? S.aptr(nxt) : cA; const char* nB = has_next ? S.bptr(nxt) : cB;
        for (int t = 0; t < nt; t += 2) {
            const bool last = (t == nt - 2);
            const char* a1 = cA + (size_t)(t + 1) * kstep;
            const char* a2 = last ? nA : cA + (size_t)(t + 2) * kstep; const char* b2 = last ? nB : cB + (size_t)(t + 2) * kstep;
            const char* a3 = a2 + kstep; const char* b3 = b2 + kstep;
            PG8_LDB(B0, 0, 0); PG8_SCHED; PG8_LDA(At, 0, 0); PG8_STAGE(PG8_SA(1, 1), a1 + hstep, voffA);
            PG8_WAIT_L(8); PG8_BAR; PG8_WAIT_L(0); PG8_MMA(0, 0, At, B0); PG8_BAR; PG8_SCHED;
            PG8_LDB(B1, 0, 1); PG8_STAGE(PG8_SB(0, 0), b2, voffB);
            PG8_BAR; PG8_WAIT_L(0); PG8_MMA(0, 1, At, B1); PG8_BAR;
            PG8_LDA(At, 0, 1); PG8_STAGE(PG8_SA(0, 0), a2, voffA);
            PG8_BAR; PG8_WAIT_L(0); PG8_MMA(1, 0, At, B0); PG8_BAR; PG8_SCHED;
            PG8_STAGE(PG8_SB(0, 1), b2 + hstep, voffB);
            PG8_WAIT_V(6); PG8_BAR; PG8_MMA(1, 1, At, B1); PG8_BAR;
            PG8_LDB(B0, 1, 0); PG8_SCHED; PG8_LDA(At, 1, 0); PG8_STAGE(PG8_SA(0, 1), a2 + hstep, voffA);
            PG8_WAIT_L(8); PG8_BAR; PG8_WAIT_L(0); PG8_MMA(0, 0, At, B0); PG8_BAR; PG8_SCHED;
            PG8_LDB(B1, 1, 1); PG8_STAGE(PG8_SB(1, 0), b3, voffB);
            PG8_BAR; PG8_WAIT_L(0); PG8_MMA(0, 1, At, B1); PG8_BAR;
            PG8_LDA(At, 1, 1); PG8_STAGE(PG8_SA(1, 0), a3, voffA);
            PG8_BAR; PG8_WAIT_L(0); PG8_MMA(1, 0, At, B0); PG8_BAR; PG8_SCHED;
            PG8_STAGE(PG8_SB(1, 1), b3 + hstep, voffB);
            PG8_WAIT_V(6); PG8_BAR; PG8_MMA(1, 1, At, B1); PG8_BAR;
        }
        if constexpr (!Epi::AFTER_DRAIN) E(acc, cur, wr, wc, fr, fq);
        if (!has_next) break;
#pragma unroll
        for (int a = 0; a < 2; ++a)
#pragma unroll
            for (int b = 0; b < 2; ++b)
#pragma unroll
                for (int m = 0; m < 4; ++m)
#pragma unroll
                    for (int n = 0; n < 2; ++n) acc[a][b][m][n] = (f32x4){0.f, 0.f, 0.f, 0.f};
        cur = nxt; cA = nA; cB = nB; ++ui;
    }
    PG8_WAIT_V(0);
    if (wr == 0) PG8_BAR;
    PG8_BAR;
    if constexpr (Epi::AFTER_DRAIN) E.fused(acc, cur, wr, wc, fr, fq, (char*)lds);
#undef PG8_SA
#undef PG8_SB
#undef PG8_STAGE
#undef PG8_LDA
#undef PG8_LDB
#undef PG8_MMA
#undef PG8_WAIT_V
#undef PG8_WAIT_L
#undef PG8_BAR
#undef PG8_SCHED
}

template <int MODE> struct EpiRows {
  static constexpr bool AFTER_DRAIN = false;
  bf16_t* O; int ldc; const float* rstd;
  __device__ __forceinline__ void operator()(const f32x4 (&acc)[2][2][4][2], const Unit& u, int wr, int wc, int fr, int fq) const {
    const int row0 = u.pm * BM + wr * 64 + fr, col0 = u.pn * BM + wc * 32 + 8 * fq;
#pragma unroll
    for (int ai = 0; ai < 2; ++ai)
#pragma unroll
      for (int m = 0; m < 4; ++m) {
        const int row = row0 + ai * HALF + m * 16;
        const float rs = (MODE == 1 || MODE == 2) ? rstd[row] : 1.0f;
        bf16_t* rowp = O + (size_t)row * ldc + col0;
#pragma unroll
        for (int bj = 0; bj < 2; ++bj) {
          f32x4 v0 = acc[ai][bj][m][0] * rs, v1 = acc[ai][bj][m][1] * rs;
          if (MODE == 2 || MODE == 3) {
#pragma unroll
            for (int j = 0; j < 4; ++j) { const float a = fmaxf(v0[j], 0.f), b = fmaxf(v1[j], 0.f); v0[j] = a * a; v1[j] = b * b; }
          }
          u32x4 w; w.x = cvt_pk_bf16(v0[0], v0[1]); w.y = cvt_pk_bf16(v0[2], v0[3]); w.z = cvt_pk_bf16(v1[0], v1[1]); w.w = cvt_pk_bf16(v1[2], v1[3]);
          *(u32x4*)(rowp + bj * HALF) = w;
        }
      }
  }
};

struct EpiRetQKV {
  static constexpr bool AFTER_DRAIN = false;
  unsigned char* ws; int qd; const float* ldf; const float* ldb;
  __device__ __forceinline__ void operator()(const f32x4 (&acc)[2][2][4][2], const Unit& u, int wr, int wc, int fr, int fq) const {
    bf16_t* QQ = reinterpret_cast<bf16_t*>(ws + off_qq(qd & 1)); bf16_t* KQ = reinterpret_cast<bf16_t*>(ws + OFF_KQ);
    bf16_t* KFT = reinterpret_cast<bf16_t*>(ws + OFF_KFT); bf16_t* KBT = reinterpret_cast<bf16_t*>(ws + OFF_KBT);
    bf16_t* VT = reinterpret_cast<bf16_t*>(ws + off_vt(qd & 1));
    const float* rstd_q = reinterpret_cast<const float*>(ws + OFF_RSTD) + qd * 4096;
    if (u.kind == 0) {
      EpiRows<1> e{QQ, 1024, rstd_q};
      e(acc, u, wr, wc, fr, fq);
    } else {
      const int r0 = wr * 64 + fr;
      const bool isk = u.pm < 4;
#pragma unroll
      for (int bj = 0; bj < 2; ++bj) {
        const int lt0 = u.pn * BM + bj * HALF + wc * 32 + 8 * fq;
        const int lb = lt0 >> 11, s0 = lt0 & 2047;
        const f32x4 ra = *(const f32x4*)(rstd_q + lt0), rb = *(const f32x4*)(rstd_q + lt0 + 4);
        if (isk) {
          const int h = u.pm;
          const float lf2 = ldf[h] * LOG2E, lb2 = ldb[h] * LOG2E;
          const int j0 = s0 & 255;
          const float f0 = __builtin_amdgcn_exp2f(lf2 * (float)(255 - j0)), gfi = __builtin_amdgcn_exp2f(-lf2), b0 = __builtin_amdgcn_exp2f(lb2 * (float)j0), gb = __builtin_amdgcn_exp2f(lb2);
          float df[8], db[8];
          df[0] = f0; db[0] = b0;
#pragma unroll
          for (int e = 1; e < 8; ++e) { df[e] = df[e - 1] * gfi; db[e] = db[e - 1] * gb; }
#pragma unroll
          for (int ai = 0; ai < 2; ++ai)
#pragma unroll
            for (int m = 0; m < 4; ++m) {
              const int d = r0 + ai * HALF + m * 16;
              const f32x4 v0 = acc[ai][bj][m][0] * ra, v1 = acc[ai][bj][m][1] * rb;
              const size_t o = ((size_t)((((lb * 4 + h) * 2 + (d >> 7)) * 8 + (s0 >> 8)) * 128 + (d & 127))) * 256 + (s0 & 255);
              u32x4 w;
              w.x = cvt_pk_bf16(v0[0] * df[0], v0[1] * df[1]); w.y = cvt_pk_bf16(v0[2] * df[2], v0[3] * df[3]);
              w.z = cvt_pk_bf16(v1[0] * df[4], v1[1] * df[5]); w.w = cvt_pk_bf16(v1[2] * df[6], v1[3] * df[7]);
              *(u32x4*)(KFT + o) = w;
              w.x = cvt_pk_bf16(v0[0] * db[0], v0[1] * db[1]); w.y = cvt_pk_bf16(v0[2] * db[2], v0[3] * db[3]);
              w.z = cvt_pk_bf16(v1[0] * db[4], v1[1] * db[5]); w.w = cvt_pk_bf16(v1[2] * db[6], v1[3] * db[7]);
              *(u32x4*)(KBT + o) = w;
              bf16_t* kq = KQ + (size_t)lt0 * 1024 + h * 256 + d;
#pragma unroll
              for (int e = 0; e < 4; ++e) { kq[(size_t)e * 1024] = (bf16_t)f2bf(v0[e]); kq[(size_t)(e + 4) * 1024] = (bf16_t)f2bf(v1[e]); }
            }
        } else {
#pragma unroll
          for (int ai = 0; ai < 2; ++ai)
#pragma unroll
            for (int m = 0; m < 4; ++m) {
              const int vrow = (u.pm - 4) * 256 + r0 + ai * HALF + m * 16;
              const int h = vrow >> 9, ee = vrow & 511;
              const f32x4 v0 = acc[ai][bj][m][0] * ra, v1 = acc[ai][bj][m][1] * rb;
              u32x4 w; w.x = cvt_pk_bf16(v0[0], v0[1]); w.y = cvt_pk_bf16(v0[2], v0[3]); w.z = cvt_pk_bf16(v1[0], v1[1]); w.w = cvt_pk_bf16(v1[2], v1[3]);
              *(u32x4*)(VT + ((size_t)((((lb * 4 + h) * 4 + (ee >> 7)) * 8 + (s0 >> 8)) * 128 + (ee & 127))) * 256 + (s0 & 255)) = w;
            }
        }
      }
    }
  }
};

struct EpiAttnIn {
  static constexpr bool AFTER_DRAIN = false;
  unsigned char* ws;
  __device__ __forceinline__ void operator()(const f32x4 (&acc)[2][2][4][2], const Unit& u, int wr, int wc, int fr, int fq) const {
    bf16_t* AQ = reinterpret_cast<bf16_t*>(ws + OFF_AQ); bf16_t* AK = reinterpret_cast<bf16_t*>(ws + OFF_AK);
    bf16_t* AVT = reinterpret_cast<bf16_t*>(ws + OFF_AVT);
    const float* rstd = reinterpret_cast<const float*>(ws + OFF_RSTD);
    if (u.kind == 0) {
      if (u.pn < 4) { EpiRows<1> e{AQ, 1024, rstd}; e(acc, u, wr, wc, fr, fq); }
      else { Unit u2 = u; u2.pn = 0; EpiRows<1> e{AK, 256, rstd}; e(acc, u2, wr, wc, fr, fq); }
    } else {
      const int r0 = wr * 64 + fr;
#pragma unroll
      for (int bj = 0; bj < 2; ++bj) {
        const int t0 = u.pn * BM + bj * HALF + wc * 32 + 8 * fq;
        const int b = t0 >> 11, s0 = t0 & 2047;
        const f32x4 ra = *(const f32x4*)(rstd + t0), rb = *(const f32x4*)(rstd + t0 + 4);
#pragma unroll
        for (int ai = 0; ai < 2; ++ai)
#pragma unroll
          for (int m = 0; m < 4; ++m) {
            const int vrow = r0 + ai * HALF + m * 16;
            const int kvh = vrow >> 6, d = vrow & 63;
            const f32x4 v0 = acc[ai][bj][m][0] * ra, v1 = acc[ai][bj][m][1] * rb;
            u32x4 w; w.x = cvt_pk_bf16(v0[0], v0[1]); w.y = cvt_pk_bf16(v0[2], v0[3]); w.z = cvt_pk_bf16(v1[0], v1[1]); w.w = cvt_pk_bf16(v1[2], v1[3]);
            *(u32x4*)(AVT + ((size_t)((b * 4 + kvh) * 64 + d)) * 2048 + s0) = w;
          }
      }
    }
  }
};

template <bool PRE, bool FIN, bool SQ> struct EpiResid {
  static constexpr bool AFTER_DRAIN = true;
  unsigned char* ws; const float* gpost; int inst; int set; float* out;
  __device__ __forceinline__ float exchange(float* part, float* xch, unsigned* flag, const Unit& u, const int tid) const {
    float mine = 0.f;
    if (tid < 256) {
      mine = (part[tid * 4 + 0] + part[tid * 4 + 1]) + (part[tid * 4 + 2] + part[tid * 4 + 3]);
      __hip_atomic_store(xch + (size_t)(u.pm * 4 + u.pn) * 256 + tid, mine, __ATOMIC_RELAXED, __HIP_MEMORY_SCOPE_AGENT);
    }
    asm volatile("s_waitcnt vmcnt(0)" ::: "memory");
    __syncthreads();
    if (tid == 0) {
      __hip_atomic_fetch_add(flag, 1u, __ATOMIC_RELAXED, __HIP_MEMORY_SCOPE_AGENT);
      const unsigned need = 4u * (unsigned)(inst + 1);
      unsigned spins = 0;
      while (__hip_atomic_load(flag, __ATOMIC_RELAXED, __HIP_MEMORY_SCOPE_AGENT) < need) { __builtin_amdgcn_s_sleep(1); if (++spins > (1u << 24)) break; }
    }
    __syncthreads();
    float tot = mine;
    if (tid < 256) {
#pragma unroll
      for (int q = 0; q < 4; ++q)
        if (q != u.pn) tot += __hip_atomic_load(xch + (size_t)(u.pm * 4 + q) * 256 + tid, __ATOMIC_RELAXED, __HIP_MEMORY_SCOPE_AGENT);
    }
    return tot;
  }
  __device__ __forceinline__ void fused(const f32x4 (&acc)[2][2][4][2], const Unit& u, int wr, int wc, int fr, int fq, char* lds) const {
    const int tid = opaque_tid();
    unsigned char* ws = opaque_ptr(this->ws);
    float* part = reinterpret_cast<float*>(lds);
    float* rr = part + 1024;
    float* part2 = part + 1280;
    bf16_t* xb = reinterpret_cast<bf16_t*>(ws + OFF_XB);
    float* rstd = reinterpret_cast<float*>(ws + OFF_RSTD);
    float* xchA = reinterpret_cast<float*>(ws + OFF_XCH2) + (size_t)set * 2 * 64 * 4 * 256;
    float* xchB = xchA + 64 * 4 * 256;
    unsigned* flA = reinterpret_cast<unsigned*>(ws + OFF_XFLAG2) + set * 2 * 64 * 16 + u.pm * 16;
    unsigned* flB = flA + 64 * 16;
#pragma unroll
    for (int ai = 0; ai < 2; ++ai)
#pragma unroll
      for (int m = 0; m < 4; ++m) {
        float ss = 0.f;
#pragma unroll
        for (int bj = 0; bj < 2; ++bj)
#pragma unroll
          for (int n = 0; n < 2; ++n) { const f32x4 v = acc[ai][bj][m][n]; ss += v[0] * v[0] + v[1] * v[1] + v[2] * v[2] + v[3] * v[3]; }
        if (PRE) { const float ps = rstd[(size_t)u.pm * BM + ai * HALF + wr * 64 + m * 16 + fr]; ss *= ps * ps; }
        ss += __shfl_xor(ss, 16);
        ss += __shfl_xor(ss, 32);
        if (fq == 0) part[(ai * HALF + wr * 64 + m * 16 + fr) * 4 + wc] = ss;
      }
    __syncthreads();
    {
      const float tot = exchange(part, xchA, flA, u, tid);
      if (tid < 256) rr[tid] = rsqrtf(tot * (1.0f / 1024.0f) + EPSV);
    }
    __syncthreads();
#pragma unroll
    for (int ai = 0; ai < 2; ++ai)
#pragma unroll
      for (int m = 0; m < 4; ++m) {
        const int rowl = ai * HALF + wr * 64 + m * 16 + fr;
        const size_t row = (size_t)u.pm * BM + rowl;
        const float rn = PRE ? rr[rowl] * rstd[row] : rr[rowl];
        float sx = 0.f;
#pragma unroll
        for (int bj = 0; bj < 2; ++bj) {
          const int col = u.pn * BM + bj * HALF + wc * 32 + 8 * fq;
          bf16_t* xp = xb + row * 1024 + col;
          const uint4 xv = *reinterpret_cast<const uint4*>(xp);
          const f32x4 g0 = *reinterpret_cast<const f32x4*>(gpost + col), g1 = *reinterpret_cast<const f32x4*>(gpost + col + 4);
          const f32x4 h0 = acc[ai][bj][m][0], h1 = acc[ai][bj][m][1];
          uint4 o;
          { const float a0 = bf2f(xv.x & 0xffffu) + h0[0] * rn * g0[0], a1 = bf2f(xv.x >> 16) + h0[1] * rn * g0[1];
            const float a2 = bf2f(xv.y & 0xffffu) + h0[2] * rn * g0[2], a3 = bf2f(xv.y >> 16) + h0[3] * rn * g0[3];
            if (FIN) *reinterpret_cast<f32x4*>(out + row * 1024 + col) = f32x4{a0, a1, a2, a3};
            else { sx += (a0 * a0 + a1 * a1) + (a2 * a2 + a3 * a3); o.x = pack2(a0, a1); o.y = pack2(a2, a3); } }
          { const float a0 = bf2f(xv.z & 0xffffu) + h1[0] * rn * g1[0], a1 = bf2f(xv.z >> 16) + h1[1] * rn * g1[1];
            const float a2 = bf2f(xv.w & 0xffffu) + h1[2] * rn * g1[2], a3 = bf2f(xv.w >> 16) + h1[3] * rn * g1[3];
            if (FIN) *reinterpret_cast<f32x4*>(out + row * 1024 + col + 4) = f32x4{a0, a1, a2, a3};
            else { sx += (a0 * a0 + a1 * a1) + (a2 * a2 + a3 * a3); o.z = pack2(a0, a1); o.w = pack2(a2, a3); } }
          if (!FIN) *reinterpret_cast<uint4*>(xp) = o;
        }
        sx += __shfl_xor(sx, 16);
        sx += __shfl_xor(sx, 32);
        if (fq == 0) part2[rowl * 4 + wc] = sx;
      }
    if (!FIN) {
      __syncthreads();
      const float tot = exchange(part2, xchB, flB, u, tid);
      const float mean = tot * (1.0f / 1024.0f) + EPSV;
      if (tid < 256 && u.pn == 0) rstd[(size_t)u.pm * BM + tid] = SQ ? 1.0f / mean : rsqrtf(mean);
    }
  }
};
}

struct ConvItem { const float* src; const float* gain; bf16_t* dst; int K, N, kt, nt; float scale; };
__device__ __forceinline__ void conv_decode(const Params& p, unsigned char* ws, int layer, int it, const float*& src, const float*& gain, bf16_t*& dst,
                                            int& K, int& N, int& kt, int& nt, float& scale) {
  const bool ret = (layer & 1) == 0;
  const int li = layer >> 1;
  const int Nin = ret ? 6144 : 1536;
  const int Kout = ret ? 2048 : 1024;
  const int nIn = 16 * (Nin / 64), nOut = (Kout / 64) * 16;
  scale = 1.0f; gain = nullptr;
  if (it < nIn) {
    const int ntn = Nin / 64; nt = it % ntn; kt = it / ntn;
    const int n = nt * 64;
    if (ret) { if (n >= 1024 && n < 2048) scale = 0.0625f; } else { if (n < 1024) scale = 0.125f * LOG2E; }
    src = ret ? p.w_in_ret + (size_t)li * 1024 * 6144 : p.w_in_attn + (size_t)li * 1024 * 1536;
    K = 1024; N = Nin; gain = p.g_pre_mix + layer * 1024; dst = reinterpret_cast<bf16_t*>(ws + OFF_WIN);
  } else if (it < nIn + nOut) {
    const int j = it - nIn; nt = j % 16; kt = j / 16;
    src = ret ? p.w_out_ret + (size_t)li * 2048 * 1024 : p.w_out_attn + (size_t)li * 1024 * 1024;
    K = Kout; N = 1024; dst = reinterpret_cast<bf16_t*>(ws + OFF_WOUT);
  } else if (it < nIn + nOut + 1024) {
    const int j = it - nIn - nOut; nt = j % 64; kt = j / 64;
    src = p.w_up + (size_t)layer * 1024 * 4096; K = 1024; N = 4096; gain = p.g_pre_mlp + layer * 1024; dst = reinterpret_cast<bf16_t*>(ws + OFF_WUP);
  } else {
    const int j = it - nIn - nOut - 1024; nt = j % 16; kt = j / 16;
    src = p.w_down + (size_t)layer * 4096 * 1024; K = 4096; N = 1024; dst = reinterpret_cast<bf16_t*>(ws + OFF_WDN);
  }
}
#define CONV_LOAD(it_, V0, V1, V2, V3, G0, G1, G2, G3, DST, KK, KT, NT) do { \
    const float* _src; const float* _gain; int _N; float _sc; \
    conv_decode(p, ws, layer, (it_), _src, _gain, DST, KK, _N, KT, NT, _sc); \
    const int _kk = tid >> 4, _n4 = (tid & 15) * 4; \
    const float* _b = _src + (size_t)(KT * 64 + _kk) * _N + NT * 64 + _n4; \
    V0 = *reinterpret_cast<const float4*>(_b);                       V1 = *reinterpret_cast<const float4*>(_b + (size_t)16 * _N); \
    V2 = *reinterpret_cast<const float4*>(_b + (size_t)32 * _N);     V3 = *reinterpret_cast<const float4*>(_b + (size_t)48 * _N); \
    G0 = (_gain ? _gain[KT * 64 + _kk] : 1.0f) * _sc;      G1 = (_gain ? _gain[KT * 64 + _kk + 16] : 1.0f) * _sc; \
    G2 = (_gain ? _gain[KT * 64 + _kk + 32] : 1.0f) * _sc; G3 = (_gain ? _gain[KT * 64 + _kk + 48] : 1.0f) * _sc; } while (0)
#define CONV_PUT1(V, G, i_) do { const int _kk = (tid >> 4) + (i_) * 16, _n4 = (tid & 15) * 4; \
    tl[_kk * 65 + _n4 + 0] = V.x * G; tl[_kk * 65 + _n4 + 1] = V.y * G; tl[_kk * 65 + _n4 + 2] = V.z * G; tl[_kk * 65 + _n4 + 3] = V.w * G; } while (0)
#define CONV_STORE(V0, V1, V2, V3, G0, G1, G2, G3, DST, KK, KT, NT) do { \
    __syncthreads(); \
    CONV_PUT1(V0, G0, 0); CONV_PUT1(V1, G1, 1); CONV_PUT1(V2, G2, 2); CONV_PUT1(V3, G3, 3); \
    __syncthreads(); \
    _Pragma("unroll") for (int _i = 0; _i < 2; ++_i) { \
      const int _c = tid + _i * 256, _n = _c >> 3, _kc = _c & 7; \
      uint4 _o; \
      _o.x = pack2(tl[(_kc * 8 + 0) * 65 + _n], tl[(_kc * 8 + 1) * 65 + _n]); \
      _o.y = pack2(tl[(_kc * 8 + 2) * 65 + _n], tl[(_kc * 8 + 3) * 65 + _n]); \
      _o.z = pack2(tl[(_kc * 8 + 4) * 65 + _n], tl[(_kc * 8 + 5) * 65 + _n]); \
      _o.w = pack2(tl[(_kc * 8 + 6) * 65 + _n], tl[(_kc * 8 + 7) * 65 + _n]); \
      *reinterpret_cast<uint4*>(DST + (size_t)(NT * 64 + _n) * KK + KT * 64 + _kc * 8) = _o; } } while (0)

__device__ __forceinline__ void convert_layer(const Params& p, int layer, char* lds, const int which = 3, const int b0 = 0, const int nb = 256) {
  unsigned char* ws = opaque_ptr(p.ws);
  const int tidf = opaque_tid();
  const int half = tidf >> 8, tid = tidf & 255;
  float* tl = reinterpret_cast<float*>(lds + half * 65536);
  const bool ret = (layer & 1) == 0;
  const int nIn = 16 * ((ret ? 6144 : 1536) / 64), nOut = ((ret ? 2048 : 1024) / 64) * 16;
  const int first = (which & 1) ? 0 : nIn + nOut;
  const int total = ((which & 2) ? nIn + nOut + 2048 : nIn + nOut) - first;
  for (int q4 = (int)blockIdx.x - b0; q4 < total / 4; q4 += nb) {
    const int ita = first + q4 * 4 + half * 2, itb = ita + 1;
    float4 a0, a1, a2, a3, b0, b1, b2, b3; float ga0, ga1, ga2, ga3, gb0, gb1, gb2, gb3;
    bf16_t* da; bf16_t* db; int Ka, Kb, kta, ktb, nta, ntb;
    CONV_LOAD(ita, a0, a1, a2, a3, ga0, ga1, ga2, ga3, da, Ka, kta, nta);
    CONV_LOAD(itb, b0, b1, b2, b3, gb0, gb1, gb2, gb3, db, Kb, ktb, ntb);
    CONV_STORE(a0, a1, a2, a3, ga0, ga1, ga2, ga3, da, Ka, kta, nta);
    CONV_STORE(b0, b1, b2, b3, gb0, gb1, gb2, gb3, db, Kb, ktb, ntb);
  }
}
#undef CONV_LOAD
#undef CONV_PUT1
#undef CONV_STORE

__device__ __forceinline__ void phase_init(const Params& p) {
  const int tid = opaque_tid();
  const int lane = tid & 63, wid = tid >> 6;
  bf16_t* xb = reinterpret_cast<bf16_t*>(p.ws + OFF_XB);
  float* rstd = reinterpret_cast<float*>(p.ws + OFF_RSTD);
  for (int row = blockIdx.x * 8 + wid; row < T_TOK; row += gridDim.x * 8) {
    float ss = 0.f;
#pragma unroll
    for (int i = 0; i < 4; ++i) {
      const size_t o = (size_t)row * 1024 + i * 256 + lane * 4;
      const float4 v = *reinterpret_cast<const float4*>(p.x + o);
      ss += v.x * v.x + v.y * v.y + v.z * v.z + v.w * v.w;
      uint2 b; b.x = pack2(v.x, v.y); b.y = pack2(v.z, v.w);
      *reinterpret_cast<uint2*>(xb + o) = b;
    }
    ss = wave_sum(ss);
    if (lane == 0) rstd[row] = rsqrtf(ss * (1.0f / 1024.0f) + EPSV);
  }
}

template <bool FINAL, bool SQ>
__device__ __forceinline__ void phase_resid(const Params& p, const float* __restrict__ gpost) {
  const int tid = opaque_tid();
  const int lane = tid & 63, wid = tid >> 6;
  bf16_t* xb = reinterpret_cast<bf16_t*>(p.ws + OFF_XB);
  const bf16_t* hbuf = reinterpret_cast<const bf16_t*>(p.ws + OFF_HB);
  float* rstd = reinterpret_cast<float*>(p.ws + OFF_RSTD);
  constexpr int NR = 4;
  float4 gv[4];
#pragma unroll
  for (int i = 0; i < 4; ++i) gv[i] = *reinterpret_cast<const float4*>(gpost + i * 256 + lane * 4);
  for (int row0 = (blockIdx.x * 8 + wid) * NR; row0 < T_TOK; row0 += gridDim.x * 8 * NR) {
    uint2 hb[NR][4], xx[NR][4];
#pragma unroll
    for (int q = 0; q < NR; ++q)
#pragma unroll
      for (int i = 0; i < 4; ++i) {
        const size_t o = (size_t)(row0 + q) * 1024 + i * 256 + lane * 4;
        hb[q][i] = *reinterpret_cast<const uint2*>(hbuf + o);
        xx[q][i] = *reinterpret_cast<const uint2*>(xb + o);
      }
#pragma unroll
    for (int q = 0; q < NR; ++q) {
      float hv[16], xv[16];
      float ss = 0.f;
#pragma unroll
      for (int i = 0; i < 4; ++i) {
        hv[i * 4 + 0] = bf2f(hb[q][i].x & 0xffffu); hv[i * 4 + 1] = bf2f(hb[q][i].x >> 16);
        hv[i * 4 + 2] = bf2f(hb[q][i].y & 0xffffu); hv[i * 4 + 3] = bf2f(hb[q][i].y >> 16);
        xv[i * 4 + 0] = bf2f(xx[q][i].x & 0xffffu); xv[i * 4 + 1] = bf2f(xx[q][i].x >> 16);
        xv[i * 4 + 2] = bf2f(xx[q][i].y & 0xffffu); xv[i * 4 + 3] = bf2f(xx[q][i].y >> 16);
#pragma unroll
        for (int e = 0; e < 4; ++e) ss += hv[i * 4 + e] * hv[i * 4 + e];
      }
      ss = wave_sum(ss);
      const float rh = rsqrtf(ss * (1.0f / 1024.0f) + EPSV);
      float sx = 0.f;
#pragma unroll
      for (int i = 0; i < 4; ++i) {
        const int c = i * 256 + lane * 4;
        xv[i * 4 + 0] += hv[i * 4 + 0] * rh * gv[i].x; xv[i * 4 + 1] += hv[i * 4 + 1] * rh * gv[i].y;
        xv[i * 4 + 2] += hv[i * 4 + 2] * rh * gv[i].z; xv[i * 4 + 3] += hv[i * 4 + 3] * rh * gv[i].w;
#pragma unroll
        for (int e = 0; e < 4; ++e) sx += xv[i * 4 + e] * xv[i * 4 + e];
        const size_t o = (size_t)(row0 + q) * 1024 + c;
        if (FINAL) {
          *reinterpret_cast<float4*>(p.out + o) = float4{xv[i * 4 + 0], xv[i * 4 + 1], xv[i * 4 + 2], xv[i * 4 + 3]};
        } else {
          uint2 b; b.x = pack2(xv[i * 4 + 0], xv[i * 4 + 1]); b.y = pack2(xv[i * 4 + 2], xv[i * 4 + 3]);
          *reinterpret_cast<uint2*>(xb + o) = b;
        }
      }
      if (!FINAL) {
        sx = wave_sum(sx);
        if (lane == 0) rstd[row0 + q] = SQ ? 1.0f / (sx * (1.0f / 1024.0f) + EPSV) : rsqrtf(sx * (1.0f / 1024.0f) + EPSV);
      }
    }
  }
}

__device__ __forceinline__ void ret_normalize(const Params& p, int qd) {
  unsigned char* ws = opaque_ptr(p.ws);
  const int tid = opaque_tid();
  const int lane = tid & 63, wid = tid >> 6;
  bf16_t* ABUF = reinterpret_cast<bf16_t*>(ws + OFF_ABUF);
  const float* opart = reinterpret_cast<const float*>(ws + OFF_OPART);
  for (int row = qd * 4096 + blockIdx.x * 8 + wid; row < (qd + 1) * 4096; row += gridDim.x * 8) {
#pragma unroll
    for (int i = 0; i < 4; ++i) {
      const float4 a = *reinterpret_cast<const float4*>(opart + (size_t)row * 32 + i * 8);
      const float4 b = *reinterpret_cast<const float4*>(opart + (size_t)row * 32 + i * 8 + 4);
      const float s = ((a.x + a.y) + (a.z + a.w)) + ((b.x + b.y) + (b.z + b.w));
      const float r = rsqrtf(s * (1.0f / 512.0f) + EPSV);
      bf16_t* ap = ABUF + (size_t)row * 2048 + i * 512 + lane * 8;
      uint4 v = *reinterpret_cast<const uint4*>(ap);
      uint4 o;
      o.x = pack2(bf2f(v.x & 0xffffu) * r, bf2f(v.x >> 16) * r);
      o.y = pack2(bf2f(v.y & 0xffffu) * r, bf2f(v.y >> 16) * r);
      o.z = pack2(bf2f(v.z & 0xffffu) * r, bf2f(v.z >> 16) * r);
      o.w = pack2(bf2f(v.w & 0xffffu) * r, bf2f(v.w >> 16) * r);
      *reinterpret_cast<uint4*>(ap) = o;
    }
  }
}


__device__ __forceinline__ void ret_s_tile(const Params& p, int li, int idx, unsigned char* ws, char* lds, const int tid, const int par) {
  const bf16_t* QQ = reinterpret_cast<const bf16_t*>(ws + off_qq(par));
  const bf16_t* KQ = reinterpret_cast<const bf16_t*>(ws + OFF_KQ);
  bf16_t* PQ = reinterpret_cast<bf16_t*>(ws + OFF_PQ);
  const int lane = tid & 63, wid = tid >> 6, wm = wid >> 2, wn = wid & 3, r = lane & 15, quad = lane >> 4;
  const int ni = idx & 1, mi = (idx >> 1) & 1, c = (idx >> 2) & 7, h = (idx >> 5) & 3, lb = idx >> 7;
  const bf16_t* A = QQ + (size_t)(lb * 2048 + c * 256 + mi * 128) * 1024 + h * 256;
  const bf16_t* B = KQ + (size_t)(lb * 2048 + c * 256 + ni * 128) * 1024 + h * 256;
  f32x4 acc[4][2];
#pragma unroll
  for (int ms = 0; ms < 4; ++ms) { acc[ms][0] = f32x4{0.f, 0.f, 0.f, 0.f}; acc[ms][1] = f32x4{0.f, 0.f, 0.f, 0.f}; }
  gemm8<2>(acc, 4, A, B, nullptr, nullptr, nullptr, 1024 | (1024 << 16), 0.f, 0.f, 0.f, 0.f, 0.f, 0.f, 0.f, 0.f, lds, tid);
  const float lf2 = p.ldf[li * 4 + h] * LOG2E, lb2 = p.ldb[li * 4 + h] * LOG2E;
  bf16_t* dst = PQ + ((size_t)(((lb * 4 + h) * 8 + c) * 256 + mi * 128)) * 256 + ni * 128;
#pragma unroll
  for (int ms = 0; ms < 4; ++ms) {
    const int m = wm * 64 + ms * 16 + r;
    const int i = mi * 128 + m;
#pragma unroll
    for (int ns = 0; ns < 2; ++ns) {
      const int n0 = wn * 32 + ns * 16 + quad * 4;
      const int j0 = ni * 128 + n0;
      const f32x4 v = acc[ms][ns];
      float o[4];
#pragma unroll
      for (int e = 0; e < 4; ++e) {
        const int diff = i - (j0 + e);
        const float dec = __builtin_amdgcn_exp2f(diff >= 0 ? lf2 * (float)diff : -lb2 * (float)diff);
        o[e] = v[e] * dec;
      }
      uint2 ov; ov.x = pack2(o[0], o[1]); ov.y = pack2(o[2], o[3]);
      *reinterpret_cast<uint2*>(dst + (size_t)m * 256 + n0) = ov;
    }
  }
}

__device__ __forceinline__ void ret_states_chain(const Params& p, int layer, int qd, char* lds) {
  unsigned char* ws = opaque_ptr(p.ws);
  const bf16_t* KFT = reinterpret_cast<const bf16_t*>(ws + OFF_KFT);
  const bf16_t* KBT = reinterpret_cast<const bf16_t*>(ws + OFF_KBT);
  const bf16_t* VT = reinterpret_cast<const bf16_t*>(ws + off_vt(qd & 1));
  bf16_t* RQ = reinterpret_cast<bf16_t*>(ws + OFF_RQ);
  const int li = layer >> 1;
  const int tid = opaque_tid();
  const int pair = blockIdx.x & 7, sub = blockIdx.x >> 3;
  const int ki = sub & 1, vi = (sub >> 1) & 3, dir = (sub >> 3) & 1, h = pair & 3, lb = pair >> 2;
  const bf16_t* Ab = VT + ((size_t)((lb * 4 + h) * 4 + vi)) * 8 * 32768;
  const bf16_t* Bb = (dir ? KBT : KFT) + ((size_t)((lb * 4 + h) * 2 + ki)) * 8 * 32768;
  const float lg2 = (dir ? p.ldb[li * 4 + h] : p.ldf[li * 4 + h]) * LOG2E;
  const float cd = exp2f(lg2 * 256.0f);
  const bf16_t* Rbase = RQ + ((size_t)((((lb * 4 + h) * 2 + dir) * 7) * 512 + vi * 128)) * 256 + ki * 128;
  f32x4 acc[4][2];
#pragma unroll
  for (int ms = 0; ms < 4; ++ms) { acc[ms][0] = f32x4{0.f, 0.f, 0.f, 0.f}; acc[ms][1] = f32x4{0.f, 0.f, 0.f, 0.f}; }
  gemm8<0>(acc, 28, Ab, Bb, Rbase, nullptr, nullptr, dir, cd, 0.f, 0.f, 0.f, 0.f, 0.f, 0.f, 0.f, lds, tid);
}
__device__ __forceinline__ void ret_states_gate(const Params& p, int qd, char* lds) {
  unsigned char* ws = opaque_ptr(p.ws);
  pg8::Sched2 S;
  S.A0 = (const char*)(reinterpret_cast<const bf16_t*>(ws + OFF_XB) + (size_t)qd * 4096 * 1024);
  S.B0 = (const char*)(reinterpret_cast<const bf16_t*>(ws + OFF_WIN) + (size_t)4096 * 1024);
  S.A1 = S.A0; S.B1 = S.B0;
  S.nM0 = 16; S.nN0 = 8; S.nM1 = 0; S.nN1 = 0; S.G = 128; S.c = (int)blockIdx.x - 128; S.tstep = (size_t)256 * 1024 * 2;
  pg8::EpiRows<1> E{reinterpret_cast<bf16_t*>(ws + OFF_ABUF) + (size_t)qd * 4096 * 2048, 2048, reinterpret_cast<const float*>(ws + OFF_RSTD) + qd * 4096};
  pg8::gemm_phase((PG8_LAS unsigned char*)lds, 1024, S, E);
}
__device__ __forceinline__ void ret_states_s(const Params& p, int layer, int qd, char* lds) {
  unsigned char* ws = opaque_ptr(p.ws);
  const int tid = opaque_tid();
  const int li = layer >> 1;
  ret_s_tile(p, li, ((int)blockIdx.x & 7) * 32 + ((int)blockIdx.x >> 3), ws, lds, tid, qd & 1);
}

__device__ __forceinline__ void ret_output(const Params& p, int layer, int qd, char* lds) {
  const int inst = (layer >> 1) * 4 + qd;
  unsigned char* ws = opaque_ptr(p.ws);
  const bf16_t* QQ = reinterpret_cast<const bf16_t*>(ws + off_qq(qd & 1));
  const bf16_t* VT = reinterpret_cast<const bf16_t*>(ws + off_vt(qd & 1));
  const bf16_t* RQ = reinterpret_cast<const bf16_t*>(ws + OFF_RQ);
  const bf16_t* PQ = reinterpret_cast<const bf16_t*>(ws + OFF_PQ);
  bf16_t* ABUF = reinterpret_cast<bf16_t*>(ws + OFF_ABUF);
  float* opart = reinterpret_cast<float*>(ws + OFF_OPART);
  const int li = layer >> 1;
  const int tid = opaque_tid();
  const int lane = tid & 63, wid = tid >> 6, wm = wid >> 2, wn = wid & 3, r = lane & 15, quad = lane >> 4;
  {
    const int xcd = blockIdx.x & 7, slot = blockIdx.x >> 3;
    const int grp = xcd * 16 + (slot >> 1);
    const int vp = slot & 1, tt = grp & 15, h = (grp >> 4) & 3, lb = grp >> 6;
    const int c = tt >> 1, mi = tt & 1;
    const bf16_t* Aq = QQ + (size_t)(lb * 2048 + tt * 128) * 1024 + h * 256;
    const float lf2 = p.ldf[li * 4 + h] * LOG2E, lb2 = p.ldb[li * 4 + h] * LOG2E;
    f32x4 acc[4][4];
    zero_acc(acc);
    {
      const bf16_t* Rf = RQ + ((size_t)((((lb * 4 + h) * 2 + 0) * 7 + (c > 0 ? c - 1 : 0)) * 512 + vp * 256)) * 256;
      const bf16_t* Rb = RQ + ((size_t)((((lb * 4 + h) * 2 + 1) * 7 + (c < 7 ? c : 0)) * 512 + vp * 256)) * 256;
      const bf16_t* Pp = PQ + ((size_t)(((lb * 4 + h) * 8 + c) * 256 + mi * 128)) * 256;
      const bf16_t* V0 = VT + ((size_t)(((lb * 4 + h) * 4 + vp * 2) * 8 + c)) * 32768;
      const bf16_t* V1 = VT + ((size_t)(((lb * 4 + h) * 4 + vp * 2 + 1) * 8 + c)) * 32768;
      float f00, f01, f02, f03, f10, f11, f12, f13;
#define RO_FAC(ms, F0, F1) do { const int i = mi * 128 + wm * 64 + (ms) * 16 + r; \
        const float ef = lf2 * (float)(i + 1), eb = lb2 * (float)(256 - i); \
        F0 = __builtin_amdgcn_exp2f((c < 7) ? ef - eb : ef);     \
        F1 = __builtin_amdgcn_exp2f(eb); } while (0)
      RO_FAC(0, f00, f10); RO_FAC(1, f01, f11); RO_FAC(2, f02, f12); RO_FAC(3, f03, f13);
#undef RO_FAC
      const int nseg = (c > 0 ? 1 : 0) + (c < 7 ? 1 : 0) + 1;
      gemm8w(acc, nseg * 4, Aq, Rf, Rb, Pp, V0, V1, c, f00, f01, f02, f03, f10, f11, f12, f13, lds, tid);
    }
    {
      float* part = reinterpret_cast<float*>(lds);
      float ssv[4];
#pragma unroll
      for (int ms = 0; ms < 4; ++ms) {
        float ss = 0.f;
#pragma unroll
        for (int ns = 0; ns < 4; ++ns) { const f32x4 o = acc[ms][ns]; ss += o[0] * o[0] + o[1] * o[1] + o[2] * o[2] + o[3] * o[3]; }
        ss += __shfl_xor(ss, 16);
        ss += __shfl_xor(ss, 32);
        ssv[ms] = ss;
        if (quad == 0) part[(wm * 64 + ms * 16 + r) * 4 + wn] = ss;
      }
      __syncthreads();
      float* xch = reinterpret_cast<float*>(ws + OFF_XCH);
      unsigned* xflag = reinterpret_cast<unsigned*>(ws + OFF_XFLAG) + grp * 16;
      float mine = 0.f;
      if (tid < 128) {
        mine = (part[tid * 4 + 0] + part[tid * 4 + 1]) + (part[tid * 4 + 2] + part[tid * 4 + 3]);
        __hip_atomic_store(xch + (size_t)(grp * 2 + vp) * 128 + tid, mine, __ATOMIC_RELAXED, __HIP_MEMORY_SCOPE_AGENT);
      }
      asm volatile("s_waitcnt vmcnt(0)" ::: "memory");
      __syncthreads();
      if (tid == 0) {
        __hip_atomic_fetch_add(xflag, 1u, __ATOMIC_RELAXED, __HIP_MEMORY_SCOPE_AGENT);
        const unsigned need = 2u * (unsigned)(inst + 1);
        unsigned spins = 0;
        while (__hip_atomic_load(xflag, __ATOMIC_RELAXED, __HIP_MEMORY_SCOPE_AGENT) < need) {
          __builtin_amdgcn_s_sleep(1);
          if (++spins > (1u << 24)) break;
        }
      }
      __syncthreads();
      if (tid < 128) {
        const float other = __hip_atomic_load(xch + (size_t)(grp * 2 + (1 - vp)) * 128 + tid, __ATOMIC_RELAXED, __HIP_MEMORY_SCOPE_AGENT);
        part[512 + tid] = rsqrtf((mine + other) * (1.0f / 512.0f) + EPSV);
      }
      __syncthreads();
      float rnv[4];
#pragma unroll
      for (int ms = 0; ms < 4; ++ms) rnv[ms] = part[512 + wm * 64 + ms * 16 + r];
      __syncthreads();
#pragma unroll
      for (int ms = 0; ms < 4; ++ms) {
        const int m = wm * 64 + ms * 16 + r;
        const int t = qd * 4096 + lb * 2048 + tt * 128 + m;
        const float rn = rnv[ms];
#pragma unroll
        for (int ns = 0; ns < 4; ++ns) {
          const int col = h * 512 + vp * 256 + wn * 64 + ns * 16 + quad * 4;
          const f32x4 o = acc[ms][ns] * rn;
          bf16_t* gp = ABUF + (size_t)t * 2048 + col;
          const uint2 gb = *reinterpret_cast<const uint2*>(gp);
          const float g0 = bf2f(gb.x & 0xffffu), g1 = bf2f(gb.x >> 16), g2 = bf2f(gb.y & 0xffffu), g3 = bf2f(gb.y >> 16);
          uint2 ov;
          ov.x = pack2(g0 / (1.f + __expf(-g0)) * o[0], g1 / (1.f + __expf(-g1)) * o[1]);
          ov.y = pack2(g2 / (1.f + __expf(-g2)) * o[2], g3 / (1.f + __expf(-g3)) * o[3]);
          *reinterpret_cast<uint2*>(gp) = ov;
        }
      }
      (void)ssv;
    }
  }
}

constexpr int AT_VPITCH = 656;
constexpr int AT_VOFF = 320 * 128;
template <bool INTERIOR>
__device__ __forceinline__ void attn_qtile(const bf16_t* AQ, bf16_t* AO, const char* lds, const int b, const int t0, const int qo, const int head,
                                           const int r, const int quad, const float sink2, const float slope2, const float (&bd)[4]) {
      const bf16_t* qp = AQ + (size_t)(b * 2048 + t0 + qo + r) * 1024 + head * 64 + quad * 8;
      const bf16x8 qf0 = *reinterpret_cast<const bf16x8*>(qp);
      const bf16x8 qf1 = *reinterpret_cast<const bf16x8*>(qp + 32);
      f32x4 s[18];
      s[17] = f32x4{0.f, 0.f, 0.f, 0.f};
#pragma unroll
      for (int kt = 0; kt < 17; ++kt) {
        const int row = qo + kt * 16 + r;
        const char* kp = lds + row * 128;
        const bf16x8 kf0 = *reinterpret_cast<const bf16x8*>(kp + (((0 + quad) ^ (row & 7)) << 4));
        const bf16x8 kf1 = *reinterpret_cast<const bf16x8*>(kp + (((4 + quad) ^ (row & 7)) << 4));
        f32x4 a = {0.f, 0.f, 0.f, 0.f};
        a = __builtin_amdgcn_mfma_f32_16x16x32_bf16(kf0, qf0, a, 0, 0, 0);
        a = __builtin_amdgcn_mfma_f32_16x16x32_bf16(kf1, qf1, a, 0, 0, 0);
        s[kt] = a;
      }
      float mx = sink2;
      if (INTERIOR) {
#pragma unroll
        for (int kt = 0; kt < 17; ++kt) {
#pragma unroll
          for (int j = 0; j < 4; ++j) {
            const float e = bd[j] - (float)(kt * 16);
            float sc = fmaf(-slope2, fabsf(e), s[kt][j]);
            if (kt == 0) sc = (e <= 128.0f) ? sc : -1e30f;
            if (kt == 16) sc = (e >= -128.0f) ? sc : -1e30f;
            s[kt][j] = sc;
            mx = fmaxf(mx, sc);
          }
        }
      } else {
        const float tqf = (float)(t0 + qo + r);
        const float hi = fminf(128.0f, tqf), lo = fmaxf(-128.0f, tqf - 2047.0f);
#pragma unroll
        for (int kt = 0; kt < 17; ++kt) {
#pragma unroll
          for (int j = 0; j < 4; ++j) {
            const float e = bd[j] - (float)(kt * 16);
            const float sc = (e <= hi && e >= lo) ? fmaf(-slope2, fabsf(e), s[kt][j]) : -1e30f;
            s[kt][j] = sc;
            mx = fmaxf(mx, sc);
          }
        }
      }
      mx = fmaxf(mx, __shfl_xor(mx, 16));
      mx = fmaxf(mx, __shfl_xor(mx, 32));
      float sum = 0.f;
#pragma unroll
      for (int kt = 0; kt < 17; ++kt) {
#pragma unroll
        for (int j = 0; j < 4; ++j) {
          const float pv = __builtin_amdgcn_exp2f(s[kt][j] - mx);
          s[kt][j] = pv;
          sum += pv;
        }
      }
      sum += __shfl_xor(sum, 16);
      sum += __shfl_xor(sum, 32);
      sum += __builtin_amdgcn_exp2f(sink2 - mx);
      const float inv = 1.0f / sum;
      f32x4 o[4];
#pragma unroll
      for (int dt = 0; dt < 4; ++dt) o[dt] = f32x4{0.f, 0.f, 0.f, 0.f};
#pragma unroll
      for (int st = 0; st < 9; ++st) {
        union { uint4 u; bf16x8 v; } pb;
        pb.u.x = pack2(s[2 * st][0], s[2 * st][1]);
        pb.u.y = pack2(s[2 * st][2], s[2 * st][3]);
        pb.u.z = pack2(s[2 * st + 1][0], s[2 * st + 1][1]);
        pb.u.w = pack2(s[2 * st + 1][2], s[2 * st + 1][3]);
        const int kl = qo + st * 32 + quad * 4;
#pragma unroll
        for (int dt = 0; dt < 4; ++dt) {
          const char* vp = lds + AT_VOFF + (dt * 16 + r) * AT_VPITCH + kl * 2;
          const uint2 xa = *reinterpret_cast<const uint2*>(vp);
          const uint2 xb2 = *reinterpret_cast<const uint2*>(vp + 32);
          union { uint4 u; bf16x8 v; } af;
          af.u.x = xa.x; af.u.y = xa.y; af.u.z = xb2.x; af.u.w = xb2.y;
          o[dt] = __builtin_amdgcn_mfma_f32_16x16x32_bf16(af.v, pb.v, o[dt], 0, 0, 0);
        }
      }
#pragma unroll
      for (int dt = 0; dt < 4; ++dt) {
        uint2 ov; ov.x = pack2(o[dt][0] * inv, o[dt][1] * inv); ov.y = pack2(o[dt][2] * inv, o[dt][3] * inv);
        *reinterpret_cast<uint2*>(AO + (size_t)(b * 2048 + t0 + qo + r) * 1024 + head * 64 + dt * 16 + quad * 4) = ov;
      }
}

__device__ __forceinline__ void attn_core(const Params& p, int layer, char* lds) {
  unsigned char* ws = opaque_ptr(p.ws);
  const bf16_t* AQ = reinterpret_cast<const bf16_t*>(ws + OFF_AQ);
  const bf16_t* AK = reinterpret_cast<const bf16_t*>(ws + OFF_AK);
  const bf16_t* AVT = reinterpret_cast<const bf16_t*>(ws + OFF_AVT);
  bf16_t* AO = reinterpret_cast<bf16_t*>(ws + OFF_AO);
  const int li = layer >> 1;
  const int tid = opaque_tid();
  const int lane = tid & 63, wid8 = tid >> 6, wid = wid8 & 3, r = lane & 15, quad = lane >> 4;
  for (int k4 = 0; k4 < 4; ++k4) {
    const int item = ((int)blockIdx.x & 7) * 128 + ((int)blockIdx.x >> 3) * 4 + k4;
    const int qb = item & 31, kvh = (item >> 5) & 3, b = item >> 7;
    const int t0 = qb * 64, ks = t0 - 128;
    __syncthreads();
#pragma unroll
    for (int i = 0; i < 5; ++i) {
      const int c = tid + i * 512;
      {
        const int row = c >> 3, kc = c & 7, key = ks + row;
        uint4 v = {0u, 0u, 0u, 0u};
        if (key >= 0 && key < 2048) v = *reinterpret_cast<const uint4*>(AK + (size_t)(b * 2048 + key) * 256 + kvh * 64 + kc * 8);
        *reinterpret_cast<uint4*>(lds + row * 128 + ((kc ^ (row & 7)) << 4)) = v;
      }
      {
        const int d = c / 40, kc = c - d * 40, key = ks + kc * 8;
        uint4 v = {0u, 0u, 0u, 0u};
        if (key >= 0 && key < 2048) v = *reinterpret_cast<const uint4*>(AVT + ((size_t)((b * 4 + kvh) * 64 + d)) * 2048 + key);
        *reinterpret_cast<uint4*>(lds + AT_VOFF + d * AT_VPITCH + kc * 16) = v;
      }
    }
    __syncthreads();
    const int head = kvh * 4 + wid;
    const float sink2 = p.sink[li * 16 + head] * LOG2E;
    const float slope2 = exp2f(-0.5f * (float)(head + 1)) * LOG2E;
    float bd[4];
#pragma unroll
    for (int j = 0; j < 4; ++j) bd[j] = (float)(r + 128 - quad * 4 - j);
#pragma unroll 1
    for (int jq = 0; jq < 2; ++jq) {
      const int qo = ((wid8 >> 2) * 2 + jq) * 16;
      if ((t0 >= 128) && (t0 + 192 <= 2048)) attn_qtile<true>(AQ, AO, lds, b, t0, qo, head, r, quad, sink2, slope2, bd);
      else                                  attn_qtile<false>(AQ, AO, lds, b, t0, qo, head, r, quad, sink2, slope2, bd);
    }
  }
}

template <int MODE>
__device__ __forceinline__ void big_gemm(char* lds, const bf16_t* A, const bf16_t* W, int M, int N, int K, bf16_t* C, int ldc, const float* rstd) {
  pg8::Sched2 S;
  S.A0 = (const char*)A; S.B0 = (const char*)W; S.A1 = S.A0; S.B1 = S.B0;
  S.nM0 = M / 256; S.nN0 = N / 256; S.nM1 = 0; S.nN1 = 0; S.G = (int)gridDim.x; S.c = (int)blockIdx.x; S.tstep = (size_t)256 * K * 2;
  pg8::EpiRows<MODE> E{C, ldc, rstd};
  pg8::gemm_phase(( PG8_LAS unsigned char*)lds, K, S, E);
}

template <bool PRE, bool FIN, bool SQ>
__device__ __forceinline__ void proj_resid(char* lds, unsigned char* ws, const bf16_t* A, const bf16_t* W, int K, const float* gpost, int inst, int set, float* out) {
  pg8::Sched2 S;
  S.A0 = (const char*)A; S.B0 = (const char*)W; S.A1 = S.A0; S.B1 = S.B0;
  S.nM0 = 64; S.nN0 = 4; S.nM1 = 0; S.nN1 = 0; S.G = (int)gridDim.x; S.c = (int)blockIdx.x; S.tstep = (size_t)256 * K * 2;
  pg8::EpiResid<PRE, FIN, SQ> E{ws, gpost, inst, set, out};
  pg8::gemm_phase((PG8_LAS unsigned char*)lds, K, S, E);
}

__global__ void __launch_bounds__(512, 2) fwd_megakernel(Params p, int never) {
  extern __shared__ __attribute__((aligned(16))) char lds[];
  volatile LAS unsigned* st = (volatile LAS unsigned*)(lds + LDS_STAGE);
  if (threadIdx.x == 0) { st[0] = 0u; st[1] = 0u; st[2] = 0u; st[3] = 0u; }
  __syncthreads();
  if (never == 0x7fffabcd) { cg::this_grid().sync(); }
    (void)xcd_barrier_post(reinterpret_cast<unsigned*>(p.ws + OFF_BAR), st);

  phase_init(p);
  convert_layer(p, 0, lds);
  xcd_barrier(XcdBarrier{reinterpret_cast<unsigned*>(p.ws + OFF_BAR), xb_xcc_id(), (volatile LAS unsigned*)(lds + LDS_STAGE)});

#pragma unroll 1
  for (int layer = 0; layer < 4; ++layer) {
    if ((layer & 1) == 0) {
      const int li = layer >> 1;
#define RET_QKV(qd_) do { \
          pg8::Sched2 S; \
          S.A0 = (const char*)((reinterpret_cast<bf16_t*>(p.ws + OFF_XB)) + (size_t)(qd_) * 4096 * 1024); S.B0 = (const char*)(reinterpret_cast<const bf16_t*>(p.ws + OFF_WIN));                            \
          S.A1 = (const char*)((reinterpret_cast<const bf16_t*>(p.ws + OFF_WIN)) + (size_t)1024 * 1024);    S.B1 = (const char*)((reinterpret_cast<bf16_t*>(p.ws + OFF_XB)) + (size_t)(qd_) * 4096 * 1024);     \
          S.nM0 = 16; S.nN0 = 4; S.nM1 = 12; S.nN1 = 16; S.G = (int)gridDim.x; S.c = (int)blockIdx.x; S.tstep = (size_t)256 * 1024 * 2; \
          pg8::EpiRetQKV E{(p.ws), (qd_), p.ldf + li * 4, p.ldb + li * 4}; \
          pg8::gemm_phase((PG8_LAS unsigned char*)lds, 1024, S, E); } while (0)
      if (layer > 0) { convert_layer(p, layer, lds, 2); __syncthreads(); }
      RET_QKV(0);
      xcd_barrier(XcdBarrier{reinterpret_cast<unsigned*>(p.ws + OFF_BAR), xb_xcc_id(), (volatile LAS unsigned*)(lds + LDS_STAGE)});
#pragma unroll 1
      for (int qd = 0; qd < 4; ++qd) {
        if (blockIdx.x < 128) ret_states_chain(p, layer, qd, lds);
        else ret_states_gate(p, qd, lds);
        ret_states_s(p, layer, qd, lds);
        xcd_barrier(XcdBarrier{reinterpret_cast<unsigned*>(p.ws + OFF_BAR), xb_xcc_id(), (volatile LAS unsigned*)(lds + LDS_STAGE)});
        ret_output(p, layer, qd, lds);
        if (qd < 3) RET_QKV(qd + 1);
        xcd_barrier(XcdBarrier{reinterpret_cast<unsigned*>(p.ws + OFF_BAR), xb_xcc_id(), (volatile LAS unsigned*)(lds + LDS_STAGE)});
      }
#undef RET_QKV
      proj_resid<false, false, true>(lds, (p.ws), reinterpret_cast<const bf16_t*>((p.ws) + OFF_ABUF), (reinterpret_cast<const bf16_t*>(p.ws + OFF_WOUT)), 2048, p.g_post_mix + layer * 1024, layer, 0, nullptr);
      xcd_barrier(XcdBarrier{reinterpret_cast<unsigned*>(p.ws + OFF_BAR), xb_xcc_id(), (volatile LAS unsigned*)(lds + LDS_STAGE)});
    } else {
      if (blockIdx.x >= 128) { convert_layer(p, layer, lds, 2, 128, 128); __syncthreads(); }
      {
        pg8::Sched2 S;
        S.A0 = (const char*)(reinterpret_cast<bf16_t*>(p.ws + OFF_XB)); S.B0 = (const char*)(reinterpret_cast<const bf16_t*>(p.ws + OFF_WIN));
        S.A1 = (const char*)((reinterpret_cast<const bf16_t*>(p.ws + OFF_WIN)) + (size_t)1280 * 1024); S.B1 = (const char*)(reinterpret_cast<bf16_t*>(p.ws + OFF_XB));
        S.nM0 = 64; S.nN0 = 5; S.nM1 = 1; S.nN1 = 64; S.G = (int)gridDim.x; S.c = (int)blockIdx.x; S.tstep = (size_t)256 * 1024 * 2;
        pg8::EpiAttnIn E{(p.ws)};
        pg8::gemm_phase((PG8_LAS unsigned char*)lds, 1024, S, E);
      }
      xcd_barrier(XcdBarrier{reinterpret_cast<unsigned*>(p.ws + OFF_BAR), xb_xcc_id(), (volatile LAS unsigned*)(lds + LDS_STAGE)});
      attn_core(p, layer, lds);
      xcd_barrier(XcdBarrier{reinterpret_cast<unsigned*>(p.ws + OFF_BAR), xb_xcc_id(), (volatile LAS unsigned*)(lds + LDS_STAGE)});
      proj_resid<false, false, true>(lds, (p.ws), reinterpret_cast<const bf16_t*>((p.ws) + OFF_AO), (reinterpret_cast<const bf16_t*>(p.ws + OFF_WOUT)), 1024, p.g_post_mix + layer * 1024, layer, 0, nullptr);
      xcd_barrier(XcdBarrier{reinterpret_cast<unsigned*>(p.ws + OFF_BAR), xb_xcc_id(), (volatile LAS unsigned*)(lds + LDS_STAGE)});
    }
    if (layer < 3) { convert_layer(p, layer + 1, lds, 1); __syncthreads(); }
    big_gemm<3>(lds, (reinterpret_cast<bf16_t*>(p.ws + OFF_XB)), reinterpret_cast<const bf16_t*>((p.ws) + OFF_WUP), 16384, 4096, 1024, reinterpret_cast<bf16_t*>((p.ws) + OFF_HID), 4096, nullptr);
    xcd_barrier(XcdBarrier{reinterpret_cast<unsigned*>(p.ws + OFF_BAR), xb_xcc_id(), (volatile LAS unsigned*)(lds + LDS_STAGE)});
    if (layer < 3) {
      proj_resid<true, false, false>(lds, (p.ws), reinterpret_cast<const bf16_t*>((p.ws) + OFF_HID), reinterpret_cast<const bf16_t*>((p.ws) + OFF_WDN), 4096,
                                     p.g_post_mlp + layer * 1024, layer, 1, nullptr);
      xcd_barrier(XcdBarrier{reinterpret_cast<unsigned*>(p.ws + OFF_BAR), xb_xcc_id(), (volatile LAS unsigned*)(lds + LDS_STAGE)});
    } else {
      proj_resid<true, true, false>(lds, (p.ws), reinterpret_cast<const bf16_t*>((p.ws) + OFF_HID), reinterpret_cast<const bf16_t*>((p.ws) + OFF_WDN), 4096,
                                    p.g_post_mlp + layer * 1024, layer, 1, p.out);
    }
  }
}


extern "C" void kernel_launch(void* const* d_in, const int* in_sizes, int n_in, void* d_out, int out_size,
                              void* d_ws, size_t ws_size, hipStream_t stream) {
  static int grid_blocks = 0;
  if (!grid_blocks) {
    int dev = 0, cus = 0, per_cu = 0;
    (void)hipGetDevice(&dev);
    (void)hipDeviceGetAttribute(&cus, hipDeviceAttributeMultiprocessorCount, dev);
    (void)hipFuncSetAttribute((const void*)fwd_megakernel, hipFuncAttributeMaxDynamicSharedMemorySize, LDS_BYTES);
    (void)hipOccupancyMaxActiveBlocksPerMultiprocessor(&per_cu, (const void*)fwd_megakernel, 512, LDS_BYTES);
    if (per_cu < 1) fprintf(stderr, "kernel_launch: occupancy query reports %d blocks per CU\n", per_cu);
    grid_blocks = 256;
    if (cus < 256) fprintf(stderr, "kernel_launch: %d CUs < 256: the grid will not be co-resident\n", cus);
    if (ws_size < WS_NEED) fprintf(stderr, "kernel_launch: workspace too small: %zu < %zu\n", ws_size, (size_t)WS_NEED);
  }
  (void)hipMemsetAsync((char*)d_ws + OFF_BAR, 0, 40960, stream);
  Params p{};
  p.x = (const float*)d_in[0]; p.w_in_ret = (const float*)d_in[1]; p.w_out_ret = (const float*)d_in[2];
  p.ldf = (const float*)d_in[3]; p.ldb = (const float*)d_in[4]; p.w_in_attn = (const float*)d_in[5];
  p.w_out_attn = (const float*)d_in[6]; p.sink = (const float*)d_in[7]; p.g_pre_mix = (const float*)d_in[8];
  p.g_post_mix = (const float*)d_in[9]; p.g_pre_mlp = (const float*)d_in[10]; p.g_post_mlp = (const float*)d_in[11];
  p.w_up = (const float*)d_in[12]; p.w_down = (const float*)d_in[13];
  p.out = (float*)d_out; p.ws = (unsigned char*)d_ws;
  int never = 0;
  void* args[] = {&p, &never};
  hipError_t e = hipLaunchCooperativeKernel((const void*)fwd_megakernel, dim3(grid_blocks), dim3(512), args, LDS_BYTES, stream);
  if (e != hipSuccess) fprintf(stderr, "cooperative launch failed: %s (grid %d)\n", hipGetErrorString(e), grid_blocks);
}
```

```cpp
#include <hip/hip_runtime.h>
#include <hip/hip_cooperative_groups.h>
#include <stdint.h>
#include <stdio.h>
namespace cg = cooperative_groups;

typedef unsigned short bf16_t;
using bf16x8 = __attribute__((ext_vector_type(8))) short;
using f32x4  = __attribute__((ext_vector_type(4))) float;

constexpr int T_TOK = 16384, DM = 1024, SEQ = 2048;
constexpr float EPSV = 1e-6f;
constexpr float LOG2E = 1.4426950408889634f;

constexpr size_t OFF_BAR   = 0;
constexpr size_t OFF_WIN   = 16384;
constexpr size_t OFF_WOUT  = OFF_WIN  + 12582912;
constexpr size_t OFF_WUP   = OFF_WOUT + 4194304;
constexpr size_t OFF_WDN   = OFF_WUP  + 8388608;
constexpr size_t OFF_XB    = OFF_WDN  + 8388608;
constexpr size_t OFF_RSTD  = OFF_XB   + 33554432;
constexpr size_t OFF_OPART = OFF_RSTD + 65536;
constexpr size_t OFF_XFLAG = OFF_OPART;
constexpr size_t OFF_XCH   = OFF_OPART + 65536;
constexpr size_t OFF_XFLAG2 = OFF_OPART + 8192;
constexpr size_t OFF_XCH2  = OFF_OPART + 65536 + 131072;
constexpr size_t OFF_HB    = OFF_OPART + 4194304;
constexpr size_t OFF_M     = OFF_HB + 33554432;
constexpr size_t OFF_ABUF  = OFF_M;
constexpr size_t OFF_QQ    = OFF_ABUF + 67108864;
constexpr size_t OFF_KQ    = OFF_QQ  + 8388608;
constexpr size_t OFF_KFT   = OFF_KQ  + 8388608;
constexpr size_t OFF_KBT   = OFF_KFT + 8388608;
constexpr size_t OFF_VT    = OFF_KBT + 8388608;
constexpr size_t OFF_RQ    = OFF_VT  + 16777216;
constexpr size_t OFF_PQ    = OFF_RQ  + 29360128;
constexpr size_t OFF_END_R = OFF_PQ  + 8388608;
constexpr size_t OFF_AQ    = OFF_M;
constexpr size_t OFF_AK    = OFF_AQ + 33554432;
constexpr size_t OFF_AVT   = OFF_AK + 8388608;
constexpr size_t OFF_AO    = OFF_AVT + 8388608;
constexpr size_t OFF_HID   = OFF_M;
constexpr size_t WS_NEED   = OFF_END_R;
__device__ __forceinline__ size_t off_qq(int par) { return par ? OFF_HB : OFF_QQ; }
__device__ __forceinline__ size_t off_vt(int par) { return par ? OFF_HB + 8388608 : OFF_VT; }

constexpr int LDS_STAGE = 131072;
constexpr int LDS_BYTES = LDS_STAGE + 64;

struct Params {
  const float *x, *w_in_ret, *w_out_ret, *ldf, *ldb, *w_in_attn, *w_out_attn, *sink;
  const float *g_pre_mix, *g_post_mix, *g_pre_mlp, *g_post_mlp, *w_up, *w_down;
  float* out;
  unsigned char* ws;
};

__device__ __forceinline__ float bf2f(unsigned v) { return __uint_as_float(v << 16); }
__device__ __forceinline__ unsigned f2bf(float f) { unsigned u = __float_as_uint(f); u += 0x7fffu + ((u >> 16) & 1u); return u >> 16; }
typedef float f32x2_t __attribute__((ext_vector_type(2)));
typedef __bf16 bf16x2_t __attribute__((ext_vector_type(2)));
__device__ __forceinline__ unsigned pack2(float a, float b) { f32x2_t v = {a, b}; return __builtin_bit_cast(unsigned, __builtin_convertvector(v, bf16x2_t)); }
__device__ __forceinline__ int opaque_tid() { int t = (int)threadIdx.x; asm volatile("" : "+v"(t)); return t; }
__device__ __forceinline__ unsigned char* opaque_ptr(unsigned char* p) { size_t z = 0; asm volatile("" : "+s"(z)); return p + z; }
__device__ __forceinline__ float wave_sum(float v) {
#pragma unroll
  for (int o = 32; o >= 1; o >>= 1) v += __shfl_xor(v, o);
  return v;
}

#define XB_TMO      128
#define XB_XCNT(j)  (256  + 64 * (j))
#define XB_XSUB(j)  (1280 + 64 * (j))
#define XB_XGEN(j)  (2304 + 64 * (j))
#define XB_TOP      3328
#define XB_TOPGEN   3392
#define XCD_BAR_WORDS 3456
#define XB_SPIN_CAP (1u << 22)
#define LAS __attribute__((address_space(3)))

__device__ __forceinline__ unsigned xb_ld(unsigned* p)              { return __hip_atomic_load(p, __ATOMIC_RELAXED, __HIP_MEMORY_SCOPE_AGENT); }
__device__ __forceinline__ unsigned xb_add(unsigned* p, unsigned v) { return __hip_atomic_fetch_add(p, v, __ATOMIC_RELAXED, __HIP_MEMORY_SCOPE_AGENT); }
__device__ __forceinline__ unsigned xb_xcc_id() { return (unsigned)__builtin_amdgcn_s_getreg((3 << 11) | 20) & 0xFu; }
#define XB_SPIN(cond, bar) do { unsigned _sp = 0; while (cond) { __builtin_amdgcn_s_sleep(1); \
    if ((++_sp & 255u) == 0u) { if (xb_ld(&(bar)[XB_TMO])) break; if (_sp > XB_SPIN_CAP) { atomicAdd(&(bar)[XB_TMO], 1u); break; } } } } while (0)

struct XcdBarrier { unsigned* bar; unsigned x; volatile LAS unsigned* st; };

__device__ __forceinline__ XcdBarrier xcd_barrier_post(unsigned* bar, volatile LAS unsigned* st) {
  XcdBarrier b; b.bar = bar; b.x = xb_xcc_id(); b.st = st;
  if (threadIdx.x == 0) (void)xb_add(&bar[XB_XCNT(b.x)], 1u);
  return b;
}
__device__ __forceinline__ void xcd_barrier_complete(unsigned* bar, unsigned x, unsigned& nloc, unsigned& nx) {
  const unsigned G = gridDim.x * gridDim.y * gridDim.z;
  unsigned sum, cnt, mine, sp = 0u;
  for (;;) {
    sum = 0u; cnt = 0u; mine = 0u;
#pragma unroll
    for (unsigned j = 0; j < 16; ++j) { const unsigned c = xb_ld(&bar[XB_XCNT(j)]); sum += c; cnt += (c > 0u) ? 1u : 0u; mine = (j == x) ? c : mine; }
    if (sum == G) break;
    __builtin_amdgcn_s_sleep(1);
    if ((++sp & 255u) == 0u) { if (xb_ld(&bar[XB_TMO])) break; if (sp > XB_SPIN_CAP) { atomicAdd(&bar[XB_TMO], 1u); break; } }
  }
  nloc = mine > 0u ? mine : 1u; nx = cnt > 0u ? cnt : 1u;
}
__device__ __forceinline__ void xcd_barrier(const XcdBarrier& b) {
  asm volatile("s_waitcnt vmcnt(0)" ::: "memory");
  __syncthreads();
  if (threadIdx.x == 0) {
    unsigned* bar = b.bar;
    __builtin_amdgcn_s_waitcnt(0);
    unsigned nloc = b.st[0], nx = b.st[1];
    if (nloc == 0u) { xcd_barrier_complete(bar, b.x, nloc, nx); b.st[0] = nloc; b.st[1] = nx; }
    const unsigned old = xb_add(&bar[XB_XSUB(b.x)], 1u);
    const unsigned gen = old / nloc;
    if (old + 1u == (gen + 1u) * nloc) {
      __builtin_amdgcn_fence(__ATOMIC_RELEASE, "agent");
      asm volatile("s_waitcnt vmcnt(0)" ::: "memory");
      const unsigned og = xb_add(&bar[XB_TOP], 1u);
      const unsigned tg = og / nx;
      if (og + 1u == (tg + 1u) * nx) xb_add(&bar[XB_TOPGEN], 1u);
      else XB_SPIN(xb_ld(&bar[XB_TOPGEN]) == tg, bar);
      __builtin_amdgcn_fence(__ATOMIC_ACQUIRE, "agent");
      xb_add(&bar[XB_XGEN(b.x)], 1u);
      asm volatile("s_waitcnt vmcnt(0)" ::: "memory");
    } else {
      XB_SPIN(xb_ld(&bar[XB_XGEN(b.x)]) == gen, bar);
      __builtin_amdgcn_fence(__ATOMIC_ACQUIRE, "agent");
      asm volatile("s_waitcnt vmcnt(0)" ::: "memory");
    }
  }
  __syncthreads();
}

template <bool SWAP>
__device__ __forceinline__ void gemm_acc(f32x4 (&acc)[4][4], const bf16_t* __restrict__ A, int lda,
                                         const bf16_t* __restrict__ B, int ldb, int K, char* lds, const int tid) {
  const int lane = tid & 63, wid = tid >> 6;
  const int wm = wid >> 1, wn = wid & 1;
  const int r = lane & 15, quad = lane >> 4;
  const int lrow = tid >> 3, lkc = tid & 7;
  const bf16_t* Ag = A + (size_t)lrow * lda + lkc * 8;
  const bf16_t* Bg = B + (size_t)lrow * ldb + lkc * 8;
  const int wofs = lrow * 128 + ((lkc ^ (lrow & 7)) << 4);
  const int aofs = (wm * 64 + r) * 128;
  const int bofs = 16384 + (wn * 64 + r) * 128;
  const int sw = r & 7;
  uint4 ra0, ra1, ra2, ra3, rb0, rb1, rb2, rb3;
  const int nk = K >> 6;
#define G_LOAD(k0) do { \
    ra0 = *reinterpret_cast<const uint4*>(Ag + (k0));                       rb0 = *reinterpret_cast<const uint4*>(Bg + (k0)); \
    ra1 = *reinterpret_cast<const uint4*>(Ag + (size_t)32 * lda + (k0));    rb1 = *reinterpret_cast<const uint4*>(Bg + (size_t)32 * ldb + (k0)); \
    ra2 = *reinterpret_cast<const uint4*>(Ag + (size_t)64 * lda + (k0));    rb2 = *reinterpret_cast<const uint4*>(Bg + (size_t)64 * ldb + (k0)); \
    ra3 = *reinterpret_cast<const uint4*>(Ag + (size_t)96 * lda + (k0));    rb3 = *reinterpret_cast<const uint4*>(Bg + (size_t)96 * ldb + (k0)); } while (0)
#define G_STORE(buf) do { char* _d = (buf) + wofs; \
    *reinterpret_cast<uint4*>(_d) = ra0;          *reinterpret_cast<uint4*>(_d + 16384) = rb0; \
    *reinterpret_cast<uint4*>(_d + 4096) = ra1;   *reinterpret_cast<uint4*>(_d + 16384 + 4096) = rb1; \
    *reinterpret_cast<uint4*>(_d + 8192) = ra2;   *reinterpret_cast<uint4*>(_d + 16384 + 8192) = rb2; \
    *reinterpret_cast<uint4*>(_d + 12288) = ra3;  *reinterpret_cast<uint4*>(_d + 16384 + 12288) = rb3; } while (0)
#define G_COMPUTE(cur) do { \
    _Pragma("unroll") for (int ks = 0; ks < 2; ++ks) { \
      bf16x8 af0, af1, af2, af3, bf0, bf1, bf2, bf3; \
      const int co = ((ks * 4 + quad) ^ sw) << 4; \
      af0 = *reinterpret_cast<const bf16x8*>((cur) + aofs + co);        bf0 = *reinterpret_cast<const bf16x8*>((cur) + bofs + co); \
      af1 = *reinterpret_cast<const bf16x8*>((cur) + aofs + 2048 + co); bf1 = *reinterpret_cast<const bf16x8*>((cur) + bofs + 2048 + co); \
      af2 = *reinterpret_cast<const bf16x8*>((cur) + aofs + 4096 + co); bf2 = *reinterpret_cast<const bf16x8*>((cur) + bofs + 4096 + co); \
      af3 = *reinterpret_cast<const bf16x8*>((cur) + aofs + 6144 + co); bf3 = *reinterpret_cast<const bf16x8*>((cur) + bofs + 6144 + co); \
      G_MMA(0, 0, af0, bf0); G_MMA(0, 1, af0, bf1); G_MMA(0, 2, af0, bf2); G_MMA(0, 3, af0, bf3); \
      G_MMA(1, 0, af1, bf0); G_MMA(1, 1, af1, bf1); G_MMA(1, 2, af1, bf2); G_MMA(1, 3, af1, bf3); \
      G_MMA(2, 0, af2, bf0); G_MMA(2, 1, af2, bf1); G_MMA(2, 2, af2, bf2); G_MMA(2, 3, af2, bf3); \
      G_MMA(3, 0, af3, bf0); G_MMA(3, 1, af3, bf1); G_MMA(3, 2, af3, bf2); G_MMA(3, 3, af3, bf3); \
    } } while (0)
#define G_MMA(ms, ns, a, b) acc[ms][ns] = SWAP ? __builtin_amdgcn_mfma_f32_16x16x32_bf16(b, a, acc[ms][ns], 0, 0, 0) \
                                               : __builtin_amdgcn_mfma_f32_16x16x32_bf16(a, b, acc[ms][ns], 0, 0, 0)
  G_LOAD(0);
  __syncthreads();
  G_STORE(lds);
  __syncthreads();
  for (int kt = 0; kt < nk - 1; ++kt) {
    char* cur = lds + (kt & 1) * 32768;
    char* nxt = lds + ((kt + 1) & 1) * 32768;
    const int k0 = (kt + 1) * 64;
    G_LOAD(k0);
    G_COMPUTE(cur);
    G_STORE(nxt);
    __syncthreads();
  }
  {
    char* cur = lds + ((nk - 1) & 1) * 32768;
    G_COMPUTE(cur);
    __syncthreads();
  }
#undef G_LOAD
#undef G_STORE
#undef G_COMPUTE
#undef G_MMA
}


__device__ __forceinline__ void store_tile_plain(const f32x4 (&acc)[4][4], bf16_t* dst, int ld, const int tid) {
  const int lane = tid & 63, wid = tid >> 6, wm = wid >> 1, wn = wid & 1, r = lane & 15, quad = lane >> 4;
#pragma unroll
  for (int ms = 0; ms < 4; ++ms) {
    const int m = wm * 64 + ms * 16 + r;
#pragma unroll
    for (int ns = 0; ns < 4; ++ns) {
      const int n0 = wn * 64 + ns * 16 + quad * 4;
      const f32x4 v = acc[ms][ns];
      uint2 o; o.x = pack2(v[0], v[1]); o.y = pack2(v[2], v[3]);
      *reinterpret_cast<uint2*>(dst + (size_t)m * ld + n0) = o;
    }
  }
}

__device__ __forceinline__ void store_tile8(const f32x4 (&acc)[4][2], bf16_t* dst, int ld, const int tid) {
  const int lane = tid & 63, wid = tid >> 6, wm = wid >> 2, wn = wid & 3, r = lane & 15, quad = lane >> 4;
#pragma unroll
  for (int ms = 0; ms < 4; ++ms) {
    const int m = wm * 64 + ms * 16 + r;
#pragma unroll
    for (int ns = 0; ns < 2; ++ns) {
      const int n0 = wn * 32 + ns * 16 + quad * 4;
      const f32x4 v = acc[ms][ns];
      uint2 o; o.x = pack2(v[0], v[1]); o.y = pack2(v[2], v[3]);
      *reinterpret_cast<uint2*>(dst + (size_t)m * ld + n0) = o;
    }
  }
}
template <int MODE>
__device__ __forceinline__ void gm_ptrs(int g, const bf16_t* P0, const bf16_t* P1, const bf16_t* P2, const bf16_t* P3, const bf16_t* P4, int i0,
                                        const bf16_t*& A, int& lda, const bf16_t*& B, int& ldb) {
  if (MODE == 2) {
    A = P0 + g * 64; B = P1 + g * 64; lda = i0 & 0xffff; ldb = i0 >> 16;
  } else if (MODE == 0) {
    const int s = g >> 2, c = i0 ? 7 - s : s, ko = c * 256 + (g & 3) * 64;
    A = P0 + c * 32768 + (g & 3) * 64; B = P1 + c * 32768 + (g & 3) * 64; lda = 256; ldb = 256;
  } else {
    const int s = g >> 2, ty = (i0 == 0) ? s + 1 : ((i0 == 7) ? (s == 0 ? 0 : 2) : s), ko = (g & 3) * 64;
    const bool pv = (ty == 2);
    A = (pv ? P3 : P0) + ko; lda = pv ? 256 : 1024;
    const bf16_t* bsel = (ty == 0) ? P1 : P2;
    B = (pv ? P4 : bsel) + ko; ldb = 256;
  }
}
template <int MODE>
__device__ __forceinline__ void gemm8(f32x4 (&acc)[4][2], const int nsteps, const bf16_t* P0, const bf16_t* P1, const bf16_t* P2, const bf16_t* P3,
                                      const bf16_t* P4, const int i0, const float s0, const float s1, const float s2, const float s3,
                                      const float s4, const float s5, const float s6, const float s7, char* lds, const int tid) {
  const int lane = tid & 63, wid = tid >> 6;
  const int wm = wid >> 2, wn = wid & 3;
  const int r = lane & 15, quad = lane >> 4;
  const int lrow = tid >> 3, lkc = tid & 7;
  const int wofs = lrow * 128 + ((lkc ^ (lrow & 7)) << 4);
  const int aofs = (wm * 64 + r) * 128;
  const int bofs = 16384 + (wn * 32 + r) * 128;
  const int sw = r & 7;
  uint4 xa0, xa1, xb0, xb1, ya0, ya1, yb0, yb1, za0, za1, zb0, zb1, wa0, wa1, wb0, wb1;
#define GM_LOAD(g, S) do { const bf16_t* _Ap; const bf16_t* _Bp; int _lda, _ldb; gm_ptrs<MODE>((g), P0, P1, P2, P3, P4, i0, _Ap, _lda, _Bp, _ldb); \
    const bf16_t* _a = _Ap + (size_t)lrow * _lda + lkc * 8; const bf16_t* _b = _Bp + (size_t)lrow * _ldb + lkc * 8; \
    S##a0 = *reinterpret_cast<const uint4*>(_a);                       S##b0 = *reinterpret_cast<const uint4*>(_b); \
    S##a1 = *reinterpret_cast<const uint4*>(_a + (size_t)64 * _lda);   S##b1 = *reinterpret_cast<const uint4*>(_b + (size_t)64 * _ldb); } while (0)
#define GM_STORE(buf, S) do { char* _d = (buf) + wofs; \
    *reinterpret_cast<uint4*>(_d) = S##a0;          *reinterpret_cast<uint4*>(_d + 16384) = S##b0; \
    *reinterpret_cast<uint4*>(_d + 8192) = S##a1;   *reinterpret_cast<uint4*>(_d + 16384 + 8192) = S##b1; } while (0)
#define GM_MMA(ms, ns, a, b) acc[ms][ns] = __builtin_amdgcn_mfma_f32_16x16x32_bf16(b, a, acc[ms][ns], 0, 0, 0)
#define GM_COMPUTE(cur) do { \
    bf16x8 a00, a01, a02, a03, b00, b01, a10, a11, a12, a13, b10, b11; \
    const int co0 = ((0 + quad) ^ sw) << 4, co1 = ((4 + quad) ^ sw) << 4; \
    a00 = *reinterpret_cast<const bf16x8*>((cur) + aofs + co0);        b00 = *reinterpret_cast<const bf16x8*>((cur) + bofs + co0); \
    a01 = *reinterpret_cast<const bf16x8*>((cur) + aofs + 2048 + co0); b01 = *reinterpret_cast<const bf16x8*>((cur) + bofs + 2048 + co0); \
    a02 = *reinterpret_cast<const bf16x8*>((cur) + aofs + 4096 + co0); \
    a03 = *reinterpret_cast<const bf16x8*>((cur) + aofs + 6144 + co0); \
    a10 = *reinterpret_cast<const bf16x8*>((cur) + aofs + co1);        b10 = *reinterpret_cast<const bf16x8*>((cur) + bofs + co1); \
    a11 = *reinterpret_cast<const bf16x8*>((cur) + aofs + 2048 + co1); b11 = *reinterpret_cast<const bf16x8*>((cur) + bofs + 2048 + co1); \
    a12 = *reinterpret_cast<const bf16x8*>((cur) + aofs + 4096 + co1); \
    a13 = *reinterpret_cast<const bf16x8*>((cur) + aofs + 6144 + co1); \
    __builtin_amdgcn_sched_barrier(0); \
    GM_MMA(0, 0, a00, b00); GM_MMA(0, 1, a00, b01); GM_MMA(1, 0, a01, b00); GM_MMA(1, 1, a01, b01); \
    GM_MMA(2, 0, a02, b00); GM_MMA(2, 1, a02, b01); GM_MMA(3, 0, a03, b00); GM_MMA(3, 1, a03, b01); \
    GM_MMA(0, 0, a10, b10); GM_MMA(0, 1, a10, b11); GM_MMA(1, 0, a11, b10); GM_MMA(1, 1, a11, b11); \
    GM_MMA(2, 0, a12, b10); GM_MMA(2, 1, a12, b11); GM_MMA(3, 0, a13, b10); GM_MMA(3, 1, a13, b11); \
    __builtin_amdgcn_sched_barrier(0); \
  } while (0)
#define GM_PRE(g) do { if (MODE == 0 && ((g) & 3) == 0 && (g) > 0) { \
      _Pragma("unroll") for (int ms = 0; ms < 4; ++ms) _Pragma("unroll") for (int ns = 0; ns < 2; ++ns) acc[ms][ns] *= s0; } } while (0)
#define GM_POST(g) do { if (((g) & 3) == 3) { \
      if (MODE == 0) { const int _s = (g) >> 2, _c = i0 ? 7 - _s : _s, _slot = i0 ? _c - 1 : _c; \
        store_tile8(acc, const_cast<bf16_t*>(P2) + (size_t)_slot * 512 * 256, 256, tid); } \
      else if (MODE == 1) { const int _s = (g) >> 2, _ty = (i0 == 0) ? _s + 1 : ((i0 == 7) ? (_s == 0 ? 0 : 2) : _s); \
        if (_ty == 0) { _Pragma("unroll") for (int ns = 0; ns < 2; ++ns) { acc[0][ns] *= s0; acc[1][ns] *= s1; acc[2][ns] *= s2; acc[3][ns] *= s3; } } \
        else if (_ty == 1) { _Pragma("unroll") for (int ns = 0; ns < 2; ++ns) { acc[0][ns] *= s4; acc[1][ns] *= s5; acc[2][ns] *= s6; acc[3][ns] *= s7; } } } } } while (0)
  char* b0 = lds;
  char* b1 = lds + 32768;
  GM_LOAD(0, x); GM_LOAD(1, y); GM_LOAD(2, z); GM_LOAD(3, w);
  __syncthreads();
  GM_STORE(b0, x);
  __syncthreads();
  for (int g = 0; g < nsteps; g += 4) {
    const bool more = (g + 4 < nsteps);
    if (more) GM_LOAD(g + 4, x);
    GM_PRE(g);     GM_COMPUTE(b0); GM_POST(g);     GM_STORE(b1, y); __syncthreads();
    if (more) GM_LOAD(g + 5, y);
    GM_PRE(g + 1); GM_COMPUTE(b1); GM_POST(g + 1); GM_STORE(b0, z); __syncthreads();
    if (more) GM_LOAD(g + 6, z);
    GM_PRE(g + 2); GM_COMPUTE(b0); GM_POST(g + 2); GM_STORE(b1, w); __syncthreads();
    if (more) GM_LOAD(g + 7, w);
    GM_PRE(g + 3); GM_COMPUTE(b1); GM_POST(g + 3); if (more) GM_STORE(b0, x); __syncthreads();
  }
#undef GM_PRE
#undef GM_POST
#undef GM_LOAD
#undef GM_STORE
#undef GM_COMPUTE
#undef GM_MMA
}

__device__ __forceinline__ void gemm8w(f32x4 (&acc)[4][4], const int nsteps, const bf16_t* Aq, const bf16_t* Rf, const bf16_t* Rb, const bf16_t* Pp,
                                       const bf16_t* V0, const bf16_t* V1, const int c, const float s0, const float s1, const float s2, const float s3,
                                       const float s4, const float s5, const float s6, const float s7, char* lds, const int tid) {
  const int lane = tid & 63, wid = tid >> 6;
  const int wm = wid >> 2, wn = wid & 3;
  const int r = lane & 15, quad = lane >> 4;
  const int lrow = tid >> 3, lkc = tid & 7;
  const int wofs = lrow * 128 + ((lkc ^ (lrow & 7)) << 4);
  const int aofs = (wm * 64 + r) * 128;
  const int bofs = 16384 + (wn * 64 + r) * 128;
  const int sw = r & 7;
  uint4 xa0, xa1, xb0, xb1, xb2, xb3, ya0, ya1, yb0, yb1, yb2, yb3;
#define GW_TYPE(g) ((c == 0) ? ((g) >> 2) + 1 : ((c == 7) ? ((((g) >> 2) == 0) ? 0 : 2) : ((g) >> 2)))
#define GW_LOAD(g, S) do { const int _ty = GW_TYPE(g), _ko = ((g) & 3) * 64; const bool _pv = (_ty == 2); \
    const bf16_t* _a = (_pv ? Pp : Aq) + (size_t)lrow * (_pv ? 256 : 1024) + lkc * 8 + _ko; const size_t _a64 = (size_t)64 * (_pv ? 256 : 1024); \
    const bf16_t* _bs = (_ty == 0) ? Rf : Rb; \
    const bf16_t* _lo = (_pv ? V0 : _bs) + (size_t)lrow * 256 + lkc * 8 + _ko; \
    const bf16_t* _hi = (_pv ? V1 : _bs + 128 * 256) + (size_t)lrow * 256 + lkc * 8 + _ko; \
    S##a0 = *reinterpret_cast<const uint4*>(_a);        S##a1 = *reinterpret_cast<const uint4*>(_a + _a64); \
    S##b0 = *reinterpret_cast<const uint4*>(_lo);       S##b1 = *reinterpret_cast<const uint4*>(_lo + 64 * 256); \
    S##b2 = *reinterpret_cast<const uint4*>(_hi);       S##b3 = *reinterpret_cast<const uint4*>(_hi + 64 * 256); } while (0)
#define GW_STORE(buf, S) do { char* _d = (buf) + wofs; \
    *reinterpret_cast<uint4*>(_d) = S##a0;                  *reinterpret_cast<uint4*>(_d + 8192) = S##a1; \
    *reinterpret_cast<uint4*>(_d + 16384) = S##b0;          *reinterpret_cast<uint4*>(_d + 16384 + 8192) = S##b1; \
    *reinterpret_cast<uint4*>(_d + 16384 + 16384) = S##b2;  *reinterpret_cast<uint4*>(_d + 16384 + 24576) = S##b3; } while (0)
#define GW_MMA(ms, ns, a, b) acc[ms][ns] = __builtin_amdgcn_mfma_f32_16x16x32_bf16(b, a, acc[ms][ns], 0, 0, 0)
#define GW_COMPUTE(cur) do { \
    _Pragma("unroll") for (int ks = 0; ks < 2; ++ks) { \
      bf16x8 af0, af1, af2, af3, bf0, bf1, bf2, bf3; \
      const int co = ((ks * 4 + quad) ^ sw) << 4; \
      af0 = *reinterpret_cast<const bf16x8*>((cur) + aofs + co);        bf0 = *reinterpret_cast<const bf16x8*>((cur) + bofs + co); \
      af1 = *reinterpret_cast<const bf16x8*>((cur) + aofs + 2048 + co); bf1 = *reinterpret_cast<const bf16x8*>((cur) + bofs + 2048 + co); \
      af2 = *reinterpret_cast<const bf16x8*>((cur) + aofs + 4096 + co); bf2 = *reinterpret_cast<const bf16x8*>((cur) + bofs + 4096 + co); \
      af3 = *reinterpret_cast<const bf16x8*>((cur) + aofs + 6144 + co); bf3 = *reinterpret_cast<const bf16x8*>((cur) + bofs + 6144 + co); \
      __builtin_amdgcn_sched_barrier(0); \
      GW_MMA(0, 0, af0, bf0); GW_MMA(0, 1, af0, bf1); GW_MMA(0, 2, af0, bf2); GW_MMA(0, 3, af0, bf3); \
      GW_MMA(1, 0, af1, bf0); GW_MMA(1, 1, af1, bf1); GW_MMA(1, 2, af1, bf2); GW_MMA(1, 3, af1, bf3); \
      GW_MMA(2, 0, af2, bf0); GW_MMA(2, 1, af2, bf1); GW_MMA(2, 2, af2, bf2); GW_MMA(2, 3, af2, bf3); \
      GW_MMA(3, 0, af3, bf0); GW_MMA(3, 1, af3, bf1); GW_MMA(3, 2, af3, bf2); GW_MMA(3, 3, af3, bf3); \
      __builtin_amdgcn_sched_barrier(0); \
    } } while (0)
#define GW_POST(g) do { if (((g) & 3) == 3) { const int _ty = GW_TYPE(g); \
      if (_ty == 0) { _Pragma("unroll") for (int ns = 0; ns < 4; ++ns) { acc[0][ns] *= s0; acc[1][ns] *= s1; acc[2][ns] *= s2; acc[3][ns] *= s3; } } \
      else if (_ty == 1) { _Pragma("unroll") for (int ns = 0; ns < 4; ++ns) { acc[0][ns] *= s4; acc[1][ns] *= s5; acc[2][ns] *= s6; acc[3][ns] *= s7; } } } } while (0)
  char* b0 = lds;
  char* b1 = lds + 49152;
  GW_LOAD(0, x); GW_LOAD(1, y);
  __syncthreads();
  GW_STORE(b0, x);
  __syncthreads();
  for (int g = 0; g < nsteps; g += 2) {
    const bool more = (g + 2 < nsteps);
    if (more) GW_LOAD(g + 2, x);
    GW_COMPUTE(b0); GW_POST(g);     GW_STORE(b1, y); __syncthreads();
    if (more) GW_LOAD(g + 3, y);
    GW_COMPUTE(b1); GW_POST(g + 1); if (more) GW_STORE(b0, x); __syncthreads();
  }
#undef GW_TYPE
#undef GW_LOAD
#undef GW_STORE
#undef GW_MMA
#undef GW_COMPUTE
#undef GW_POST
}

__device__ __forceinline__ void zero_acc(f32x4 (&acc)[4][4]) {
#pragma unroll
  for (int ms = 0; ms < 4; ++ms)
#pragma unroll
    for (int ns = 0; ns < 4; ++ns) acc[ms][ns] = f32x4{0.f, 0.f, 0.f, 0.f};
}

__device__ __forceinline__ void store_tile_swap(const f32x4 (&acc)[4][4], bf16_t* dst, int ld, const float (&rs)[4], const int tid) {
  const int lane = tid & 63, wid = tid >> 6, wm = wid >> 1, wn = wid & 1, r = lane & 15, quad = lane >> 4;
#pragma unroll
  for (int ms = 0; ms < 4; ++ms) {
    const int m = wm * 64 + ms * 16 + r;
#pragma unroll
    for (int ns = 0; ns < 4; ++ns) {
      const int n0 = wn * 64 + ns * 16 + quad * 4;
      const f32x4 v = acc[ms][ns];
      uint2 o; o.x = pack2(v[0] * rs[ms], v[1] * rs[ms]); o.y = pack2(v[2] * rs[ms], v[3] * rs[ms]);
      *reinterpret_cast<uint2*>(dst + (size_t)m * ld + n0) = o;
    }
  }
}


namespace pg8 {
#define PG8_LAS __attribute__((address_space(3)))
typedef unsigned u32x4 __attribute__((ext_vector_type(4)));
constexpr int BM = 256, BK = 64, HALF = 128, HTB = HALF * BK * 2, NXCD = 8, WGM = 8;
__device__ __forceinline__ int lds_byte(int r, int c) { const int st = (r >> 4) * 2 + (c >> 5), rr = r & 15, cc = c & 31, ob = rr * 64 + cc * 2; return st * 1024 + (ob ^ (((ob >> 9) & 1) << 5)); }
__device__ __forceinline__ void stage_rc(int b, int& R, int& C) { const int st = b / 1024, sb = b % 1024, swz = sb ^ (((sb >> 9) & 1) << 5); R = (st >> 1) * 16 + swz / 64; C = (st & 1) * 32 + (swz % 64) / 2; }
__device__ __forceinline__ int perm32(int rho) { const int n = rho >> 4, i = rho & 15; return 8 * (i >> 2) + 4 * n + (i & 3); }
struct Unit { int pm, pn, kind; };
__device__ __forceinline__ unsigned cvt_pk_bf16(float lo, float hi) { unsigned r; asm volatile("s_nop 1\n\tv_cvt_pk_bf16_f32 %0, %1, %2" : "=v"(r) : "v"(lo), "v"(hi)); return r; }

__device__ __forceinline__ void decode_tile(int wgid, int nM, int nN, int& pm, int& pn) {
  const int nwg = nM * nN;
  { const int q = nwg / NXCD, r = nwg % NXCD, xcd = wgid % NXCD, off = wgid / NXCD; wgid = (xcd < r ? xcd * (q + 1) : r * (q + 1) + (xcd - r) * q) + off; }
  const int nig = WGM * nN, gid = wgid / nig, fm = gid * WGM, gsz = (nM - fm) < WGM ? (nM - fm) : WGM;
  pm = fm + ((wgid % nig) % gsz); pn = (wgid % nig) / gsz;
}
struct Sched2 {
  const char *A0, *B0, *A1, *B1; int nM0, nN0, nM1, nN1, G, c; size_t tstep;
  __device__ __forceinline__ bool next(int i, Unit& u) const {
    int L = i * G + c; const int n0 = nM0 * nN0, n1 = nM1 * nN1;
    if (L < n0) { u.kind = 0; decode_tile(L, nM0, nN0, u.pm, u.pn); return true; }
    L -= n0;
    if (L < n1) { u.kind = 1; decode_tile(L, nM1, nN1, u.pm, u.pn); return true; }
    return false;
  }
  __device__ __forceinline__ const char* aptr(const Unit& u) const { return (u.kind ? A1 : A0) + (size_t)u.pm * tstep; }
  __device__ __forceinline__ const char* bptr(const Unit& u) const { return (u.kind ? B1 : B0) + (size_t)u.pn * tstep; }
};

struct SchedRetQKV {
  const char *A0, *B0, *A1, *B1; size_t tstep; int xcd, slot;
  __device__ __forceinline__ bool next(int i, Unit& u) const {
    if (i != 0) return false;
    if (slot < 8) { u.kind = 0; u.pm = 2 * xcd + (slot >> 2); u.pn = slot & 3; }
    else { const int idx = slot - 8; u.kind = 1; u.pm = idx % 12; u.pn = 2 * xcd + idx / 12; }
    return true;
  }
  __device__ __forceinline__ const char* aptr(const Unit& u) const { return (u.kind ? A1 : A0) + (size_t)u.pm * tstep; }
  __device__ __forceinline__ const char* bptr(const Unit& u) const { return (u.kind ? B1 : B0) + (size_t)u.pn * tstep; }
};

template <class Epi, class Sched>
__device__ __forceinline__ void gemm_phase(PG8_LAS unsigned char* lds, const int K, const Sched& S, const Epi& E) {
    const int tid = opaque_tid(), wid = __builtin_amdgcn_readfirstlane(tid >> 6), lane = tid & 63, wr = wid >> 2, wc = wid & 3, fr = lane & 15, fq = lane >> 4;
    const int nt = K / BK;
    unsigned voffA[2], voffB[2];
#pragma unroll
    for (int i = 0; i < 2; ++i) { int R, C; stage_rc(tid * 16 + i * 8192, R, C); const int Rb = ((R & ~31) + perm32(R & 31));
        voffA[i] = (unsigned)(R * K + C) * 2u; voffB[i] = (unsigned)(Rb * K + C) * 2u; }
    const size_t kstep = (size_t)(BK * 2);
    const size_t hstep = (size_t)HALF * K * 2;
    const unsigned ldsw = (unsigned)wid * 1024u;
    const int aoff = lds_byte(wr * 64 + fr, fq * 8), boff = lds_byte(wc * 32 + fr, fq * 8);
#define PG8_SA(b, h) (((b) * 2 + (h)) * HTB)
#define PG8_SB(b, h) ((4 + (b) * 2 + (h)) * HTB)
#define PG8_STAGE(bufoff, gbase, voff) do { _Pragma("unroll") for (int _i = 0; _i < 2; ++_i) \
        __builtin_amdgcn_global_load_lds((const unsigned*)((const char*)(gbase) + (voff)[_i]), (PG8_LAS unsigned*)(lds + (bufoff) + ldsw + _i * 8192), 16, 0, 0); } while (0)
#define PG8_LDA(dst, b, h) do { _Pragma("unroll") for (int m = 0; m < 4; ++m) _Pragma("unroll") for (int k = 0; k < 2; ++k) dst[m][k] = *(const PG8_LAS bf16x8*)(lds + PG8_SA(b, h) + aoff + m * 2048 + k * 1024); } while (0)
#define PG8_LDB(dst, b, h) do { _Pragma("unroll") for (int n = 0; n < 2; ++n) _Pragma("unroll") for (int k = 0; k < 2; ++k) dst[n][k] = *(const PG8_LAS bf16x8*)(lds + PG8_SB(b, h) + boff + n * 2048 + k * 1024); } while (0)
#define PG8_MMA(ai, bj, At, Bt) do { __builtin_amdgcn_s_setprio(1); _Pragma("unroll") for (int m = 0; m < 4; ++m) _Pragma("unroll") for (int n = 0; n < 2; ++n) _Pragma("unroll") for (int k = 0; k < 2; ++k) \
        acc[ai][bj][m][n] = __builtin_amdgcn_mfma_f32_16x16x32_bf16(Bt[n][k], At[m][k], acc[ai][bj][m][n], 0, 0, 0); __builtin_amdgcn_s_setprio(0); } while (0)
#define PG8_WAIT_V(n) asm volatile("s_waitcnt vmcnt(" #n ")" ::: "memory")
#define PG8_WAIT_L(n) asm volatile("s_waitcnt lgkmcnt(" #n ")" ::: "memory")
#define PG8_BAR __builtin_amdgcn_s_barrier()
#define PG8_SCHED __builtin_amdgcn_sched_barrier(0)
    Unit cur, nxt; int ui = 0;
    if (!S.next(0, cur)) return;
    f32x4 acc[2][2][4][2];
#pragma unroll
    for (int a = 0; a < 2; ++a)
#pragma unroll
        for (int b = 0; b < 2; ++b)
#pragma unroll
            for (int m = 0; m < 4; ++m)
#pragma unroll
                for (int n = 0; n < 2; ++n) acc[a][b][m][n] = (f32x4){0.f, 0.f, 0.f, 0.f};
    bf16x8 At[4][2], B0[2][2], B1[2][2];
    const char* cA = S.aptr(cur); const char* cB = S.bptr(cur);
    PG8_STAGE(PG8_SB(0, 0), cB, voffB); PG8_STAGE(PG8_SA(0, 0), cA, voffA); PG8_STAGE(PG8_SB(0, 1), cB + hstep, voffB); PG8_STAGE(PG8_SA(0, 1), cA + hstep, voffA);
    if (wr == 1) PG8_BAR;
    PG8_WAIT_V(4); PG8_BAR;
    PG8_STAGE(PG8_SB(1, 0), cB + kstep, voffB); PG8_STAGE(PG8_SA(1, 0), cA + kstep, voffA); PG8_STAGE(PG8_SB(1, 1), cB + hstep + kstep, voffB);
    PG8_WAIT_V(6); PG8_BAR;
    for (;;) {
        const bool has_next = S.next(ui + 1, nxt);
        const char* nA = has_next ? S.aptr(nxt) : cA; const char* nB = has_next ? S.bptr(nxt) : cB;
        for (int t = 0; t < nt; t += 2) {
            const bool last = (t == nt - 2);
            const char* a1 = cA + (size_t)(t + 1) * kstep;
            const char* a2 = last ? nA : cA + (size_t)(t + 2) * kstep; const char* b2 = last ? nB : cB + (size_t)(t + 2) * kstep;
            const char* a3 = a2 + kstep; const char* b3 = b2 + kstep;
            PG8_LDB(B0, 0, 0); PG8_SCHED; PG8_LDA(At, 0, 0); PG8_STAGE(PG8_SA(1, 1), a1 + hstep, voffA);
            PG8_WAIT_L(8); PG8_BAR; PG8_WAIT_L(0); PG8_MMA(0, 0, At, B0); PG8_BAR; PG8_SCHED;
            PG8_LDB(B1, 0, 1); PG8_STAGE(PG8_SB(0, 0), b2, voffB);
            PG8_BAR; PG8_WAIT_L(0); PG8_MMA(0, 1, At, B1); PG8_BAR;
            PG8_LDA(At, 0, 1); PG8_STAGE(PG8_SA(0, 0), a2, voffA);
            PG8_BAR; PG8_WAIT_L(0); PG8_MMA(1, 0, At, B0); PG8_BAR; PG8_SCHED;
            PG8_STAGE(PG8_SB(0, 1), b2 + hstep, voffB);
            PG8_WAIT_V(6); PG8_BAR; PG8_MMA(1, 1, At, B1); PG8_BAR;
            PG8_LDB(B0, 1, 0); PG8_SCHED; PG8_LDA(At, 1, 0); PG8_STAGE(PG8_SA(0, 1), a2 + hstep, voffA);
            PG8_WAIT_L(8); PG8_BAR; PG8_WAIT_L(0); PG8_MMA(0, 0, At, B0); PG8_BAR; PG8_SCHED;
            PG8_LDB(B1, 1, 1); PG8_STAGE(PG8_SB(1, 0), b3, voffB);
            PG8_BAR; PG8_WAIT_L(0); PG8_MMA(0, 1, At, B1); PG8_BAR;
            PG8_LDA(At, 1, 1); PG8_STAGE(PG8_SA(1, 0), a3, voffA);
            PG8_BAR; PG8_WAIT_L(0); PG8_MMA(1, 0, At, B0); PG8_BAR; PG8_SCHED;
            PG8_STAGE(PG8_SB(1, 1), b3 + hstep, voffB);
            PG8_WAIT_V(6); PG8_BAR; PG8_MMA(1, 1, At, B1); PG8_BAR;
        }
        if constexpr (!Epi::AFTER_DRAIN) E(acc, cur, wr, wc, fr, fq);
        if (!has_next) break;
#pragma unroll
        for (int a = 0; a < 2; ++a)
#pragma unroll
            for (int b = 0; b < 2; ++b)
#pragma unroll
                for (int m = 0; m < 4; ++m)
#pragma unroll
                    for (int n = 0; n < 2; ++n) acc[a][b][m][n] = (f32x4){0.f, 0.f, 0.f, 0.f};
        cur = nxt; cA = nA; cB = nB; ++ui;
    }
    PG8_WAIT_V(0);
    if (wr == 0) PG8_BAR;
    PG8_BAR;
    if constexpr (Epi::AFTER_DRAIN) E.fused(acc, cur, wr, wc, fr, fq, (char*)lds);
#undef PG8_SA
#undef PG8_SB
#undef PG8_STAGE
#undef PG8_LDA
#undef PG8_LDB
#undef PG8_MMA
#undef PG8_WAIT_V
#undef PG8_WAIT_L
#undef PG8_BAR
#undef PG8_SCHED
}

template <int MODE> struct EpiRows {
  static constexpr bool AFTER_DRAIN = false;
  bf16_t* O; int ldc; const float* rstd;
  __device__ __forceinline__ void operator()(const f32x4 (&acc)[2][2][4][2], const Unit& u, int wr, int wc, int fr, int fq) const {
    const int row0 = u.pm * BM + wr * 64 + fr, col0 = u.pn * BM + wc * 32 + 8 * fq;
#pragma unroll
    for (int ai = 0; ai < 2; ++ai)
#pragma unroll
      for (int m = 0; m < 4; ++m) {
        const int row = row0 + ai * HALF + m * 16;
        const float rs = (MODE == 1 || MODE == 2) ? rstd[row] : 1.0f;
        bf16_t* rowp = O + (size_t)row * ldc + col0;
#pragma unroll
        for (int bj = 0; bj < 2; ++bj) {
          f32x4 v0 = acc[ai][bj][m][0] * rs, v1 = acc[ai][bj][m][1] * rs;
          if (MODE == 2 || MODE == 3) {
#pragma unroll
            for (int j = 0; j < 4; ++j) { const float a = fmaxf(v0[j], 0.f), b = fmaxf(v1[j], 0.f); v0[j] = a * a; v1[j] = b * b; }
          }
          u32x4 w; w.x = cvt_pk_bf16(v0[0], v0[1]); w.y = cvt_pk_bf16(v0[2], v0[3]); w.z = cvt_pk_bf16(v1[0], v1[1]); w.w = cvt_pk_bf16(v1[2], v1[3]);
          *(u32x4*)(rowp + bj * HALF) = w;
        }
      }
  }
};

struct EpiRetQKV {
  static constexpr bool AFTER_DRAIN = false;
  unsigned char* ws; int qd; const float* ldf; const float* ldb;
  __device__ __forceinline__ void operator()(const f32x4 (&acc)[2][2][4][2], const Unit& u, int wr, int wc, int fr, int fq) const {
    bf16_t* QQ = reinterpret_cast<bf16_t*>(ws + off_qq(qd & 1)); bf16_t* KQ = reinterpret_cast<bf16_t*>(ws + OFF_KQ);
    bf16_t* KFT = reinterpret_cast<bf16_t*>(ws + OFF_KFT); bf16_t* KBT = reinterpret_cast<bf16_t*>(ws + OFF_KBT);
    bf16_t* VT = reinterpret_cast<bf16_t*>(ws + off_vt(qd & 1));
    const float* rstd_q = reinterpret_cast<const float*>(ws + OFF_RSTD) + qd * 4096;
    if (u.kind == 0) {
      EpiRows<1> e{QQ, 1024, rstd_q};
      e(acc, u, wr, wc, fr, fq);
    } else {
      const int r0 = wr * 64 + fr;
      const bool isk = u.pm < 4;
#pragma unroll
      for (int bj = 0; bj < 2; ++bj) {
        const int lt0 = u.pn * BM + bj * HALF + wc * 32 + 8 * fq;
        const int lb = lt0 >> 11, s0 = lt0 & 2047;
        const f32x4 ra = *(const f32x4*)(rstd_q + lt0), rb = *(const f32x4*)(rstd_q + lt0 + 4);
        if (isk) {
          const int h = u.pm;
          const float lf2 = ldf[h] * LOG2E, lb2 = ldb[h] * LOG2E;
          const int j0 = s0 & 255;
          const float f0 = exp2f(lf2 * (float)(255 - j0)), gfi = exp2f(-lf2), b0 = exp2f(lb2 * (float)j0), gb = exp2f(lb2);
          float df[8], db[8];
          df[0] = f0; db[0] = b0;
#pragma unroll
          for (int e = 1; e < 8; ++e) { df[e] = df[e - 1] * gfi; db[e] = db[e - 1] * gb; }
#pragma unroll
          for (int ai = 0; ai < 2; ++ai)
#pragma unroll
            for (int m = 0; m < 4; ++m) {
              const int d = r0 + ai * HALF + m * 16;
              const f32x4 v0 = acc[ai][bj][m][0] * ra, v1 = acc[ai][bj][m][1] * rb;
              const size_t o = ((size_t)((((lb * 4 + h) * 2 + (d >> 7)) * 8 + (s0 >> 8)) * 128 + (d & 127))) * 256 + (s0 & 255);
              u32x4 w;
              w.x = cvt_pk_bf16(v0[0] * df[0], v0[1] * df[1]); w.y = cvt_pk_bf16(v0[2] * df[2], v0[3] * df[3]);
              w.z = cvt_pk_bf16(v1[0] * df[4], v1[1] * df[5]); w.w = cvt_pk_bf16(v1[2] * df[6], v1[3] * df[7]);
              *(u32x4*)(KFT + o) = w;
              w.x = cvt_pk_bf16(v0[0] * db[0], v0[1] * db[1]); w.y = cvt_pk_bf16(v0[2] * db[2], v0[3] * db[3]);
              w.z = cvt_pk_bf16(v1[0] * db[4], v1[1] * db[5]); w.w = cvt_pk_bf16(v1[2] * db[6], v1[3] * db[7]);
              *(u32x4*)(KBT + o) = w;
              bf16_t* kq = KQ + (size_t)lt0 * 1024 + h * 256 + d;
#pragma unroll
              for (int e = 0; e < 4; ++e) { kq[(size_t)e * 1024] = (bf16_t)f2bf(v0[e]); kq[(size_t)(e + 4) * 1024] = (bf16_t)f2bf(v1[e]); }
            }
        } else {
#pragma unroll
          for (int ai = 0; ai < 2; ++ai)
#pragma unroll
            for (int m = 0; m < 4; ++m) {
              const int vrow = (u.pm - 4) * 256 + r0 + ai * HALF + m * 16;
              const int h = vrow >> 9, ee = vrow & 511;
              const f32x4 v0 = acc[ai][bj][m][0] * ra, v1 = acc[ai][bj][m][1] * rb;
              u32x4 w; w.x = cvt_pk_bf16(v0[0], v0[1]); w.y = cvt_pk_bf16(v0[2], v0[3]); w.z = cvt_pk_bf16(v1[0], v1[1]); w.w = cvt_pk_bf16(v1[2], v1[3]);
              *(u32x4*)(VT + ((size_t)((((lb * 4 + h) * 4 + (ee >> 7)) * 8 + (s0 >> 8)) * 128 + (ee & 127))) * 256 + (s0 & 255)) = w;
            }
        }
      }
    }
  }
};

struct EpiAttnIn {
  static constexpr bool AFTER_DRAIN = false;
  unsigned char* ws;
  __device__ __forceinline__ void operator()(const f32x4 (&acc)[2][2][4][2], const Unit& u, int wr, int wc, int fr, int fq) const {
    bf16_t* AQ = reinterpret_cast<bf16_t*>(ws + OFF_AQ); bf16_t* AK = reinterpret_cast<bf16_t*>(ws + OFF_AK);
    bf16_t* AVT = reinterpret_cast<bf16_t*>(ws + OFF_AVT);
    const float* rstd = reinterpret_cast<const float*>(ws + OFF_RSTD);
    if (u.kind == 0) {
      if (u.pn < 4) { EpiRows<1> e{AQ, 1024, rstd}; e(acc, u, wr, wc, fr, fq); }
      else { Unit u2 = u; u2.pn = 0; EpiRows<1> e{AK, 256, rstd}; e(acc, u2, wr, wc, fr, fq); }
    } else {
      const int r0 = wr * 64 + fr;
#pragma unroll
      for (int bj = 0; bj < 2; ++bj) {
        const int t0 = u.pn * BM + bj * HALF + wc * 32 + 8 * fq;
        const int b = t0 >> 11, s0 = t0 & 2047;
        const f32x4 ra = *(const f32x4*)(rstd + t0), rb = *(const f32x4*)(rstd + t0 + 4);
#pragma unroll
        for (int ai = 0; ai < 2; ++ai)
#pragma unroll
          for (int m = 0; m < 4; ++m) {
            const int vrow = r0 + ai * HALF + m * 16;
            const int kvh = vrow >> 6, d = vrow & 63;
            const f32x4 v0 = acc[ai][bj][m][0] * ra, v1 = acc[ai][bj][m][1] * rb;
            u32x4 w; w.x = cvt_pk_bf16(v0[0], v0[1]); w.y = cvt_pk_bf16(v0[2], v0[3]); w.z = cvt_pk_bf16(v1[0], v1[1]); w.w = cvt_pk_bf16(v1[2], v1[3]);
            *(u32x4*)(AVT + ((size_t)((b * 4 + kvh) * 64 + d)) * 2048 + s0) = w;
          }
      }
    }
  }
};

template <bool PRE, bool FIN, bool SQ> struct EpiResid {
  static constexpr bool AFTER_DRAIN = true;
  unsigned char* ws; const float* gpost; int inst; int set; float* out;
  __device__ __forceinline__ float exchange(float* part, float* xch, unsigned* flag, const Unit& u, const int tid) const {
    float mine = 0.f;
    if (tid < 256) {
      mine = (part[tid * 4 + 0] + part[tid * 4 + 1]) + (part[tid * 4 + 2] + part[tid * 4 + 3]);
      __hip_atomic_store(xch + (size_t)(u.pm * 4 + u.pn) * 256 + tid, mine, __ATOMIC_RELAXED, __HIP_MEMORY_SCOPE_AGENT);
    }
    asm volatile("s_waitcnt vmcnt(0)" ::: "memory");
    __syncthreads();
    if (tid == 0) {
      __hip_atomic_fetch_add(flag, 1u, __ATOMIC_RELAXED, __HIP_MEMORY_SCOPE_AGENT);
      const unsigned need = 4u * (unsigned)(inst + 1);
      unsigned spins = 0;
      while (__hip_atomic_load(flag, __ATOMIC_RELAXED, __HIP_MEMORY_SCOPE_AGENT) < need) { __builtin_amdgcn_s_sleep(1); if (++spins > (1u << 24)) break; }
    }
    __syncthreads();
    float tot = mine;
    if (tid < 256) {
#pragma unroll
      for (int q = 0; q < 4; ++q)
        if (q != u.pn) tot += __hip_atomic_load(xch + (size_t)(u.pm * 4 + q) * 256 + tid, __ATOMIC_RELAXED, __HIP_MEMORY_SCOPE_AGENT);
    }
    return tot;
  }
  __device__ __forceinline__ void fused(const f32x4 (&acc)[2][2][4][2], const Unit& u, int wr, int wc, int fr, int fq, char* lds) const {
    const int tid = opaque_tid();
    unsigned char* ws = opaque_ptr(this->ws);
    float* part = reinterpret_cast<float*>(lds);
    float* rr = part + 1024;
    float* part2 = part + 1280;
    bf16_t* xb = reinterpret_cast<bf16_t*>(ws + OFF_XB);
    float* rstd = reinterpret_cast<float*>(ws + OFF_RSTD);
    float* xchA = reinterpret_cast<float*>(ws + OFF_XCH2) + (size_t)set * 2 * 64 * 4 * 256;
    float* xchB = xchA + 64 * 4 * 256;
    unsigned* flA = reinterpret_cast<unsigned*>(ws + OFF_XFLAG2) + set * 2 * 64 * 16 + u.pm * 16;
    unsigned* flB = flA + 64 * 16;
#pragma unroll
    for (int ai = 0; ai < 2; ++ai)
#pragma unroll
      for (int m = 0; m < 4; ++m) {
        float ss = 0.f;
#pragma unroll
        for (int bj = 0; bj < 2; ++bj)
#pragma unroll
          for (int n = 0; n < 2; ++n) { const f32x4 v = acc[ai][bj][m][n]; ss += v[0] * v[0] + v[1] * v[1] + v[2] * v[2] + v[3] * v[3]; }
        if (PRE) { const float ps = rstd[(size_t)u.pm * BM + ai * HALF + wr * 64 + m * 16 + fr]; ss *= ps * ps; }
        ss += __shfl_xor(ss, 16);
        ss += __shfl_xor(ss, 32);
        if (fq == 0) part[(ai * HALF + wr * 64 + m * 16 + fr) * 4 + wc] = ss;
      }
    __syncthreads();
    {
      const float tot = exchange(part, xchA, flA, u, tid);
      if (tid < 256) rr[tid] = rsqrtf(tot * (1.0f / 1024.0f) + EPSV);
    }
    __syncthreads();
#pragma unroll
    for (int ai = 0; ai < 2; ++ai)
#pragma unroll
      for (int m = 0; m < 4; ++m) {
        const int rowl = ai * HALF + wr * 64 + m * 16 + fr;
        const size_t row = (size_t)u.pm * BM + rowl;
        const float rn = PRE ? rr[rowl] * rstd[row] : rr[rowl];
        float sx = 0.f;
#pragma unroll
        for (int bj = 0; bj < 2; ++bj) {
          const int col = u.pn * BM + bj * HALF + wc * 32 + 8 * fq;
          bf16_t* xp = xb + row * 1024 + col;
          const uint4 xv = *reinterpret_cast<const uint4*>(xp);
          const f32x4 g0 = *reinterpret_cast<const f32x4*>(gpost + col), g1 = *reinterpret_cast<const f32x4*>(gpost + col + 4);
          const f32x4 h0 = acc[ai][bj][m][0], h1 = acc[ai][bj][m][1];
          uint4 o;
          { const float a0 = bf2f(xv.x & 0xffffu) + h0[0] * rn * g0[0], a1 = bf2f(xv.x >> 16) + h0[1] * rn * g0[1];
            const float a2 = bf2f(xv.y & 0xffffu) + h0[2] * rn * g0[2], a3 = bf2f(xv.y >> 16) + h0[3] * rn * g0[3];
            if (FIN) *reinterpret_cast<f32x4*>(out + row * 1024 + col) = f32x4{a0, a1, a2, a3};
            else { sx += (a0 * a0 + a1 * a1) + (a2 * a2 + a3 * a3); o.x = pack2(a0, a1); o.y = pack2(a2, a3); } }
          { const float a0 = bf2f(xv.z & 0xffffu) + h1[0] * rn * g1[0], a1 = bf2f(xv.z >> 16) + h1[1] * rn * g1[1];
            const float a2 = bf2f(xv.w & 0xffffu) + h1[2] * rn * g1[2], a3 = bf2f(xv.w >> 16) + h1[3] * rn * g1[3];
            if (FIN) *reinterpret_cast<f32x4*>(out + row * 1024 + col + 4) = f32x4{a0, a1, a2, a3};
            else { sx += (a0 * a0 + a1 * a1) + (a2 * a2 + a3 * a3); o.z = pack2(a0, a1); o.w = pack2(a2, a3); } }
          if (!FIN) *reinterpret_cast<uint4*>(xp) = o;
        }
        sx += __shfl_xor(sx, 16);
        sx += __shfl_xor(sx, 32);
        if (fq == 0) part2[rowl * 4 + wc] = sx;
      }
    if (!FIN) {
      __syncthreads();
      const float tot = exchange(part2, xchB, flB, u, tid);
      const float mean = tot * (1.0f / 1024.0f) + EPSV;
      if (tid < 256 && u.pn == 0) rstd[(size_t)u.pm * BM + tid] = SQ ? 1.0f / mean : rsqrtf(mean);
    }
  }
};
}

struct ConvItem { const float* src; const float* gain; bf16_t* dst; int K, N, kt, nt; float scale; };
__device__ __forceinline__ void conv_decode(const Params& p, unsigned char* ws, int layer, int it, const float*& src, const float*& gain, bf16_t*& dst,
                                            int& K, int& N, int& kt, int& nt, float& scale) {
  const bool ret = (layer & 1) == 0;
  const int li = layer >> 1;
  const int Nin = ret ? 6144 : 1536;
  const int Kout = ret ? 2048 : 1024;
  const int nIn = 16 * (Nin / 64), nOut = (Kout / 64) * 16;
  scale = 1.0f; gain = nullptr;
  if (it < nIn) {
    const int ntn = Nin / 64; nt = it % ntn; kt = it / ntn;
    const int n = nt * 64;
    if (ret) { if (n >= 1024 && n < 2048) scale = 0.0625f; } else { if (n < 1024) scale = 0.125f * LOG2E; }
    src = ret ? p.w_in_ret + (size_t)li * 1024 * 6144 : p.w_in_attn + (size_t)li * 1024 * 1536;
    K = 1024; N = Nin; gain = p.g_pre_mix + layer * 1024; dst = reinterpret_cast<bf16_t*>(ws + OFF_WIN);
  } else if (it < nIn + nOut) {
    const int j = it - nIn; nt = j % 16; kt = j / 16;
    src = ret ? p.w_out_ret + (size_t)li * 2048 * 1024 : p.w_out_attn + (size_t)li * 1024 * 1024;
    K = Kout; N = 1024; dst = reinterpret_cast<bf16_t*>(ws + OFF_WOUT);
  } else if (it < nIn + nOut + 1024) {
    const int j = it - nIn - nOut; nt = j % 64; kt = j / 64;
    src = p.w_up + (size_t)layer * 1024 * 4096; K = 1024; N = 4096; gain = p.g_pre_mlp + layer * 1024; dst = reinterpret_cast<bf16_t*>(ws + OFF_WUP);
  } else {
    const int j = it - nIn - nOut - 1024; nt = j % 16; kt = j / 16;
    src = p.w_down + (size_t)layer * 4096 * 1024; K = 4096; N = 1024; dst = reinterpret_cast<bf16_t*>(ws + OFF_WDN);
  }
}
#define CONV_LOAD(it_, V0, V1, V2, V3, G0, G1, G2, G3, DST, KK, KT, NT) do { \
    const float* _src; const float* _gain; int _N; float _sc; \
    conv_decode(p, ws, layer, (it_), _src, _gain, DST, KK, _N, KT, NT, _sc); \
    const int _kk = tid >> 4, _n4 = (tid & 15) * 4; \
    const float* _b = _src + (size_t)(KT * 64 + _kk) * _N + NT * 64 + _n4; \
    V0 = *reinterpret_cast<const float4*>(_b);                       V1 = *reinterpret_cast<const float4*>(_b + (size_t)16 * _N); \
    V2 = *reinterpret_cast<const float4*>(_b + (size_t)32 * _N);     V3 = *reinterpret_cast<const float4*>(_b + (size_t)48 * _N); \
    G0 = (_gain ? _gain[KT * 64 + _kk] : 1.0f) * _sc;      G1 = (_gain ? _gain[KT * 64 + _kk + 16] : 1.0f) * _sc; \
    G2 = (_gain ? _gain[KT * 64 + _kk + 32] : 1.0f) * _sc; G3 = (_gain ? _gain[KT * 64 + _kk + 48] : 1.0f) * _sc; } while (0)
#define CONV_PUT1(V, G, i_) do { const int _kk = (tid >> 4) + (i_) * 16, _n4 = (tid & 15) * 4; \
    tl[_kk * 65 + _n4 + 0] = V.x * G; tl[_kk * 65 + _n4 + 1] = V.y * G; tl[_kk * 65 + _n4 + 2] = V.z * G; tl[_kk * 65 + _n4 + 3] = V.w * G; } while (0)
#define CONV_STORE(V0, V1, V2, V3, G0, G1, G2, G3, DST, KK, KT, NT) do { \
    __syncthreads(); \
    CONV_PUT1(V0, G0, 0); CONV_PUT1(V1, G1, 1); CONV_PUT1(V2, G2, 2); CONV_PUT1(V3, G3, 3); \
    __syncthreads(); \
    _Pragma("unroll") for (int _i = 0; _i < 2; ++_i) { \
      const int _c = tid + _i * 256, _n = _c >> 3, _kc = _c & 7; \
      uint4 _o; \
      _o.x = pack2(tl[(_kc * 8 + 0) * 65 + _n], tl[(_kc * 8 + 1) * 65 + _n]); \
      _o.y = pack2(tl[(_kc * 8 + 2) * 65 + _n], tl[(_kc * 8 + 3) * 65 + _n]); \
      _o.z = pack2(tl[(_kc * 8 + 4) * 65 + _n], tl[(_kc * 8 + 5) * 65 + _n]); \
      _o.w = pack2(tl[(_kc * 8 + 6) * 65 + _n], tl[(_kc * 8 + 7) * 65 + _n]); \
      *reinterpret_cast<uint4*>(DST + (size_t)(NT * 64 + _n) * KK + KT * 64 + _kc * 8) = _o; } } while (0)

__device__ __forceinline__ void convert_layer(const Params& p, int layer, char* lds, const int which = 3, const int b0 = 0, const int nb = 256) {
  unsigned char* ws = opaque_ptr(p.ws);
  const int tidf = opaque_tid();
  const int half = tidf >> 8, tid = tidf & 255;
  float* tl = reinterpret_cast<float*>(lds + half * 65536);
  const bool ret = (layer & 1) == 0;
  const int nIn = 16 * ((ret ? 6144 : 1536) / 64), nOut = ((ret ? 2048 : 1024) / 64) * 16;
  const int first = (which & 1) ? 0 : nIn + nOut;
  const int total = ((which & 2) ? nIn + nOut + 2048 : nIn + nOut) - first;
  for (int q4 = (int)blockIdx.x - b0; q4 < total / 4; q4 += nb) {
    const int ita = first + q4 * 4 + half * 2, itb = ita + 1;
    float4 a0, a1, a2, a3, b0, b1, b2, b3; float ga0, ga1, ga2, ga3, gb0, gb1, gb2, gb3;
    bf16_t* da; bf16_t* db; int Ka, Kb, kta, ktb, nta, ntb;
    CONV_LOAD(ita, a0, a1, a2, a3, ga0, ga1, ga2, ga3, da, Ka, kta, nta);
    CONV_LOAD(itb, b0, b1, b2, b3, gb0, gb1, gb2, gb3, db, Kb, ktb, ntb);
    CONV_STORE(a0, a1, a2, a3, ga0, ga1, ga2, ga3, da, Ka, kta, nta);
    CONV_STORE(b0, b1, b2, b3, gb0, gb1, gb2, gb3, db, Kb, ktb, ntb);
  }
}
#undef CONV_LOAD
#undef CONV_PUT1
#undef CONV_STORE

__device__ __forceinline__ void phase_init(const Params& p) {
  const int tid = opaque_tid();
  const int lane = tid & 63, wid = tid >> 6;
  bf16_t* xb = reinterpret_cast<bf16_t*>(p.ws + OFF_XB);
  float* rstd = reinterpret_cast<float*>(p.ws + OFF_RSTD);
  for (int row = blockIdx.x * 8 + wid; row < T_TOK; row += gridDim.x * 8) {
    float ss = 0.f;
#pragma unroll
    for (int i = 0; i < 4; ++i) {
      const size_t o = (size_t)row * 1024 + i * 256 + lane * 4;
      const float4 v = *reinterpret_cast<const float4*>(p.x + o);
      ss += v.x * v.x + v.y * v.y + v.z * v.z + v.w * v.w;
      uint2 b; b.x = pack2(v.x, v.y); b.y = pack2(v.z, v.w);
      *reinterpret_cast<uint2*>(xb + o) = b;
    }
    ss = wave_sum(ss);
    if (lane == 0) rstd[row] = rsqrtf(ss * (1.0f / 1024.0f) + EPSV);
  }
}

template <bool FINAL, bool SQ>
__device__ __forceinline__ void phase_resid(const Params& p, const float* __restrict__ gpost) {
  const int tid = opaque_tid();
  const int lane = tid & 63, wid = tid >> 6;
  bf16_t* xb = reinterpret_cast<bf16_t*>(p.ws + OFF_XB);
  const bf16_t* hbuf = reinterpret_cast<const bf16_t*>(p.ws + OFF_HB);
  float* rstd = reinterpret_cast<float*>(p.ws + OFF_RSTD);
  constexpr int NR = 4;
  float4 gv[4];
#pragma unroll
  for (int i = 0; i < 4; ++i) gv[i] = *reinterpret_cast<const float4*>(gpost + i * 256 + lane * 4);
  for (int row0 = (blockIdx.x * 8 + wid) * NR; row0 < T_TOK; row0 += gridDim.x * 8 * NR) {
    uint2 hb[NR][4], xx[NR][4];
#pragma unroll
    for (int q = 0; q < NR; ++q)
#pragma unroll
      for (int i = 0; i < 4; ++i) {
        const size_t o = (size_t)(row0 + q) * 1024 + i * 256 + lane * 4;
        hb[q][i] = *reinterpret_cast<const uint2*>(hbuf + o);
        xx[q][i] = *reinterpret_cast<const uint2*>(xb + o);
      }
#pragma unroll
    for (int q = 0; q < NR; ++q) {
      float hv[16], xv[16];
      float ss = 0.f;
#pragma unroll
      for (int i = 0; i < 4; ++i) {
        hv[i * 4 + 0] = bf2f(hb[q][i].x & 0xffffu); hv[i * 4 + 1] = bf2f(hb[q][i].x >> 16);
        hv[i * 4 + 2] = bf2f(hb[q][i].y & 0xffffu); hv[i * 4 + 3] = bf2f(hb[q][i].y >> 16);
        xv[i * 4 + 0] = bf2f(xx[q][i].x & 0xffffu); xv[i * 4 + 1] = bf2f(xx[q][i].x >> 16);
        xv[i * 4 + 2] = bf2f(xx[q][i].y & 0xffffu); xv[i * 4 + 3] = bf2f(xx[q][i].y >> 16);
#pragma unroll
        for (int e = 0; e < 4; ++e) ss += hv[i * 4 + e] * hv[i * 4 + e];
      }
      ss = wave_sum(ss);
      const float rh = rsqrtf(ss * (1.0f / 1024.0f) + EPSV);
      float sx = 0.f;
#pragma unroll
      for (int i = 0; i < 4; ++i) {
        const int c = i * 256 + lane * 4;
        xv[i * 4 + 0] += hv[i * 4 + 0] * rh * gv[i].x; xv[i * 4 + 1] += hv[i * 4 + 1] * rh * gv[i].y;
        xv[i * 4 + 2] += hv[i * 4 + 2] * rh * gv[i].z; xv[i * 4 + 3] += hv[i * 4 + 3] * rh * gv[i].w;
#pragma unroll
        for (int e = 0; e < 4; ++e) sx += xv[i * 4 + e] * xv[i * 4 + e];
        const size_t o = (size_t)(row0 + q) * 1024 + c;
        if (FINAL) {
          *reinterpret_cast<float4*>(p.out + o) = float4{xv[i * 4 + 0], xv[i * 4 + 1], xv[i * 4 + 2], xv[i * 4 + 3]};
        } else {
          uint2 b; b.x = pack2(xv[i * 4 + 0], xv[i * 4 + 1]); b.y = pack2(xv[i * 4 + 2], xv[i * 4 + 3]);
          *reinterpret_cast<uint2*>(xb + o) = b;
        }
      }
      if (!FINAL) {
        sx = wave_sum(sx);
        if (lane == 0) rstd[row0 + q] = SQ ? 1.0f / (sx * (1.0f / 1024.0f) + EPSV) : rsqrtf(sx * (1.0f / 1024.0f) + EPSV);
      }
    }
  }
}

__device__ __forceinline__ void ret_normalize(const Params& p, int qd) {
  unsigned char* ws = opaque_ptr(p.ws);
  const int tid = opaque_tid();
  const int lane = tid & 63, wid = tid >> 6;
  bf16_t* ABUF = reinterpret_cast<bf16_t*>(ws + OFF_ABUF);
  const float* opart = reinterpret_cast<const float*>(ws + OFF_OPART);
  for (int row = qd * 4096 + blockIdx.x * 8 + wid; row < (qd + 1) * 4096; row += gridDim.x * 8) {
#pragma unroll
    for (int i = 0; i < 4; ++i) {
      const float4 a = *reinterpret_cast<const float4*>(opart + (size_t)row * 32 + i * 8);
      const float4 b = *reinterpret_cast<const float4*>(opart + (size_t)row * 32 + i * 8 + 4);
      const float s = ((a.x + a.y) + (a.z + a.w)) + ((b.x + b.y) + (b.z + b.w));
      const float r = rsqrtf(s * (1.0f / 512.0f) + EPSV);
      bf16_t* ap = ABUF + (size_t)row * 2048 + i * 512 + lane * 8;
      uint4 v = *reinterpret_cast<const uint4*>(ap);
      uint4 o;
      o.x = pack2(bf2f(v.x & 0xffffu) * r, bf2f(v.x >> 16) * r);
      o.y = pack2(bf2f(v.y & 0xffffu) * r, bf2f(v.y >> 16) * r);
      o.z = pack2(bf2f(v.z & 0xffffu) * r, bf2f(v.z >> 16) * r);
      o.w = pack2(bf2f(v.w & 0xffffu) * r, bf2f(v.w >> 16) * r);
      *reinterpret_cast<uint4*>(ap) = o;
    }
  }
}


__device__ __forceinline__ void ret_s_tile(const Params& p, int li, int idx, unsigned char* ws, char* lds, const int tid, const int par) {
  const bf16_t* QQ = reinterpret_cast<const bf16_t*>(ws + off_qq(par));
  const bf16_t* KQ = reinterpret_cast<const bf16_t*>(ws + OFF_KQ);
  bf16_t* PQ = reinterpret_cast<bf16_t*>(ws + OFF_PQ);
  const int lane = tid & 63, wid = tid >> 6, wm = wid >> 2, wn = wid & 3, r = lane & 15, quad = lane >> 4;
  const int ni = idx & 1, mi = (idx >> 1) & 1, c = (idx >> 2) & 7, h = (idx >> 5) & 3, lb = idx >> 7;
  const bf16_t* A = QQ + (size_t)(lb * 2048 + c * 256 + mi * 128) * 1024 + h * 256;
  const bf16_t* B = KQ + (size_t)(lb * 2048 + c * 256 + ni * 128) * 1024 + h * 256;
  f32x4 acc[4][2];
#pragma unroll
  for (int ms = 0; ms < 4; ++ms) { acc[ms][0] = f32x4{0.f, 0.f, 0.f, 0.f}; acc[ms][1] = f32x4{0.f, 0.f, 0.f, 0.f}; }
  gemm8<2>(acc, 4, A, B, nullptr, nullptr, nullptr, 1024 | (1024 << 16), 0.f, 0.f, 0.f, 0.f, 0.f, 0.f, 0.f, 0.f, lds, tid);
  const float lf2 = p.ldf[li * 4 + h] * LOG2E, lb2 = p.ldb[li * 4 + h] * LOG2E;
  bf16_t* dst = PQ + ((size_t)(((lb * 4 + h) * 8 + c) * 256 + mi * 128)) * 256 + ni * 128;
#pragma unroll
  for (int ms = 0; ms < 4; ++ms) {
    const int m = wm * 64 + ms * 16 + r;
    const int i = mi * 128 + m;
#pragma unroll
    for (int ns = 0; ns < 2; ++ns) {
      const int n0 = wn * 32 + ns * 16 + quad * 4;
      const int j0 = ni * 128 + n0;
      const f32x4 v = acc[ms][ns];
      float o[4];
#pragma unroll
      for (int e = 0; e < 4; ++e) {
        const int diff = i - (j0 + e);
        const float dec = diff >= 0 ? exp2f(lf2 * (float)diff) : exp2f(-lb2 * (float)diff);
        o[e] = v[e] * dec;
      }
      uint2 ov; ov.x = pack2(o[0], o[1]); ov.y = pack2(o[2], o[3]);
      *reinterpret_cast<uint2*>(dst + (size_t)m * 256 + n0) = ov;
    }
  }
}

__device__ __forceinline__ void ret_states_chain(const Params& p, int layer, int qd, char* lds) {
  unsigned char* ws = opaque_ptr(p.ws);
  const bf16_t* KFT = reinterpret_cast<const bf16_t*>(ws + OFF_KFT);
  const bf16_t* KBT = reinterpret_cast<const bf16_t*>(ws + OFF_KBT);
  const bf16_t* VT = reinterpret_cast<const bf16_t*>(ws + off_vt(qd & 1));
  bf16_t* RQ = reinterpret_cast<bf16_t*>(ws + OFF_RQ);
  const int li = layer >> 1;
  const int tid = opaque_tid();
  const int pair = blockIdx.x & 7, sub = blockIdx.x >> 3;
  const int ki = sub & 1, vi = (sub >> 1) & 3, dir = (sub >> 3) & 1, h = pair & 3, lb = pair >> 2;
  const bf16_t* Ab = VT + ((size_t)((lb * 4 + h) * 4 + vi)) * 8 * 32768;
  const bf16_t* Bb = (dir ? KBT : KFT) + ((size_t)((lb * 4 + h) * 2 + ki)) * 8 * 32768;
  const float lg2 = (dir ? p.ldb[li * 4 + h] : p.ldf[li * 4 + h]) * LOG2E;
  const float cd = exp2f(lg2 * 256.0f);
  const bf16_t* Rbase = RQ + ((size_t)((((lb * 4 + h) * 2 + dir) * 7) * 512 + vi * 128)) * 256 + ki * 128;
  f32x4 acc[4][2];
#pragma unroll
  for (int ms = 0; ms < 4; ++ms) { acc[ms][0] = f32x4{0.f, 0.f, 0.f, 0.f}; acc[ms][1] = f32x4{0.f, 0.f, 0.f, 0.f}; }
  gemm8<0>(acc, 28, Ab, Bb, Rbase, nullptr, nullptr, dir, cd, 0.f, 0.f, 0.f, 0.f, 0.f, 0.f, 0.f, lds, tid);
}
__device__ __forceinline__ void ret_states_gate(const Params& p, int qd, char* lds) {
  unsigned char* ws = opaque_ptr(p.ws);
  pg8::Sched2 S;
  S.A0 = (const char*)(reinterpret_cast<const bf16_t*>(ws + OFF_XB) + (size_t)qd * 4096 * 1024);
  S.B0 = (const char*)(reinterpret_cast<const bf16_t*>(ws + OFF_WIN) + (size_t)4096 * 1024);
  S.A1 = S.A0; S.B1 = S.B0;
  S.nM0 = 16; S.nN0 = 8; S.nM1 = 0; S.nN1 = 0; S.G = 128; S.c = (int)blockIdx.x - 128; S.tstep = (size_t)256 * 1024 * 2;
  pg8::EpiRows<1> E{reinterpret_cast<bf16_t*>(ws + OFF_ABUF) + (size_t)qd * 4096 * 2048, 2048, reinterpret_cast<const float*>(ws + OFF_RSTD) + qd * 4096};
  pg8::gemm_phase((PG8_LAS unsigned char*)lds, 1024, S, E);
}
__device__ __forceinline__ void ret_states_s(const Params& p, int layer, int qd, char* lds) {
  unsigned char* ws = opaque_ptr(p.ws);
  const int tid = opaque_tid();
  const int li = layer >> 1;
  ret_s_tile(p, li, ((int)blockIdx.x & 7) * 32 + ((int)blockIdx.x >> 3), ws, lds, tid, qd & 1);
}

__device__ __forceinline__ void ret_output(const Params& p, int layer, int qd, char* lds) {
  const int inst = (layer >> 1) * 4 + qd;
  unsigned char* ws = opaque_ptr(p.ws);
  const bf16_t* QQ = reinterpret_cast<const bf16_t*>(ws + off_qq(qd & 1));
  const bf16_t* VT = reinterpret_cast<const bf16_t*>(ws + off_vt(qd & 1));
  const bf16_t* RQ = reinterpret_cast<const bf16_t*>(ws + OFF_RQ);
  const bf16_t* PQ = reinterpret_cast<const bf16_t*>(ws + OFF_PQ);
  bf16_t* ABUF = reinterpret_cast<bf16_t*>(ws + OFF_ABUF);
  float* opart = reinterpret_cast<float*>(ws + OFF_OPART);
  const int li = layer >> 1;
  const int tid = opaque_tid();
  const int lane = tid & 63, wid = tid >> 6, wm = wid >> 2, wn = wid & 3, r = lane & 15, quad = lane >> 4;
  {
    const int xcd = blockIdx.x & 7, pslot = blockIdx.x >> 3;
    const int slot = pslot < 8 ? pslot + 4 : (pslot < 12 ? pslot - 8 : (pslot < 20 ? pslot : (pslot < 24 ? pslot + 8 : pslot - 4)));
    const int grp = xcd * 16 + (slot >> 1);
    const int vp = slot & 1, tt = grp & 15, h = (grp >> 4) & 3, lb = grp >> 6;
    const int c = tt >> 1, mi = tt & 1;
    const bf16_t* Aq = QQ + (size_t)(lb * 2048 + tt * 128) * 1024 + h * 256;
    const float lf2 = p.ldf[li * 4 + h] * LOG2E, lb2 = p.ldb[li * 4 + h] * LOG2E;
    f32x4 acc[4][4];
    zero_acc(acc);
    {
      const bf16_t* Rf = RQ + ((size_t)((((lb * 4 + h) * 2 + 0) * 7 + (c > 0 ? c - 1 : 0)) * 512 + vp * 256)) * 256;
      const bf16_t* Rb = RQ + ((size_t)((((lb * 4 + h) * 2 + 1) * 7 + (c < 7 ? c : 0)) * 512 + vp * 256)) * 256;
      const bf16_t* Pp = PQ + ((size_t)(((lb * 4 + h) * 8 + c) * 256 + mi * 128)) * 256;
      const bf16_t* V0 = VT + ((size_t)(((lb * 4 + h) * 4 + vp * 2) * 8 + c)) * 32768;
      const bf16_t* V1 = VT + ((size_t)(((lb * 4 + h) * 4 + vp * 2 + 1) * 8 + c)) * 32768;
      float f00, f01, f02, f03, f10, f11, f12, f13;
#define RO_FAC(ms, F0, F1) do { const int i = mi * 128 + wm * 64 + (ms) * 16 + r; \
        const float ef = lf2 * (float)(i + 1), eb = lb2 * (float)(256 - i); \
        F0 = (c < 7) ? exp2f(ef - eb) : exp2f(ef);     \
        F1 = exp2f(eb); } while (0)
      RO_FAC(0, f00, f10); RO_FAC(1, f01, f11); RO_FAC(2, f02, f12); RO_FAC(3, f03, f13);
#undef RO_FAC
      const int nseg = (c > 0 ? 1 : 0) + (c < 7 ? 1 : 0) + 1;
      gemm8w(acc, nseg * 4, Aq, Rf, Rb, Pp, V0, V1, c, f00, f01, f02, f03, f10, f11, f12, f13, lds, tid);
    }
    {
      float* part = reinterpret_cast<float*>(lds);
      float ssv[4];
#pragma unroll
      for (int ms = 0; ms < 4; ++ms) {
        float ss = 0.f;
#pragma unroll
        for (int ns = 0; ns < 4; ++ns) { const f32x4 o = acc[ms][ns]; ss += o[0] * o[0] + o[1] * o[1] + o[2] * o[2] + o[3] * o[3]; }
        ss += __shfl_xor(ss, 16);
        ss += __shfl_xor(ss, 32);
        ssv[ms] = ss;
        if (quad == 0) part[(wm * 64 + ms * 16 + r) * 4 + wn] = ss;
      }
      __syncthreads();
      float* xch = reinterpret_cast<float*>(ws + OFF_XCH);
      unsigned* xflag = reinterpret_cast<unsigned*>(ws + OFF_XFLAG) + grp * 16;
      float mine = 0.f;
      if (tid < 128) {
        mine = (part[tid * 4 + 0] + part[tid * 4 + 1]) + (part[tid * 4 + 2] + part[tid * 4 + 3]);
        __hip_atomic_store(xch + (size_t)(grp * 2 + vp) * 128 + tid, mine, __ATOMIC_RELAXED, __HIP_MEMORY_SCOPE_AGENT);
      }
      asm volatile("s_waitcnt vmcnt(0)" ::: "memory");
      __syncthreads();
      if (tid == 0) {
        __hip_atomic_fetch_add(xflag, 1u, __ATOMIC_RELAXED, __HIP_MEMORY_SCOPE_AGENT);
        const unsigned need = 2u * (unsigned)(inst + 1);
        unsigned spins = 0;
        while (__hip_atomic_load(xflag, __ATOMIC_RELAXED, __HIP_MEMORY_SCOPE_AGENT) < need) {
          __builtin_amdgcn_s_sleep(1);
          if (++spins > (1u << 24)) break;
        }
      }
      __syncthreads();
      if (tid < 128) {
        const float other = __hip_atomic_load(xch + (size_t)(grp * 2 + (1 - vp)) * 128 + tid, __ATOMIC_RELAXED, __HIP_MEMORY_SCOPE_AGENT);
        part[512 + tid] = rsqrtf((mine + other) * (1.0f / 512.0f) + EPSV);
      }
      __syncthreads();
      float rnv[4];
#pragma unroll
      for (int ms = 0; ms < 4; ++ms) rnv[ms] = part[512 + wm * 64 + ms * 16 + r];
      __syncthreads();
#pragma unroll
      for (int ms = 0; ms < 4; ++ms) {
        const int m = wm * 64 + ms * 16 + r;
        const int t = qd * 4096 + lb * 2048 + tt * 128 + m;
        const float rn = rnv[ms];
#pragma unroll
        for (int ns = 0; ns < 4; ++ns) {
          const int col = h * 512 + vp * 256 + wn * 64 + ns * 16 + quad * 4;
          const f32x4 o = acc[ms][ns] * rn;
          bf16_t* gp = ABUF + (size_t)t * 2048 + col;
          const uint2 gb = *reinterpret_cast<const uint2*>(gp);
          const float g0 = bf2f(gb.x & 0xffffu), g1 = bf2f(gb.x >> 16), g2 = bf2f(gb.y & 0xffffu), g3 = bf2f(gb.y >> 16);
          uint2 ov;
          ov.x = pack2(g0 / (1.f + __expf(-g0)) * o[0], g1 / (1.f + __expf(-g1)) * o[1]);
          ov.y = pack2(g2 / (1.f + __expf(-g2)) * o[2], g3 / (1.f + __expf(-g3)) * o[3]);
          *reinterpret_cast<uint2*>(gp) = ov;
        }
      }
      (void)ssv;
    }
  }
}

constexpr int AT_VPITCH = 656;
constexpr int AT_VOFF = 320 * 128;
template <bool INTERIOR>
__device__ __forceinline__ void attn_qtile(const bf16_t* AQ, bf16_t* AO, const char* lds, const int b, const int t0, const int qo, const int head,
                                           const int r, const int quad, const float sink2, const float slope2, const float (&bd)[4]) {
      const bf16_t* qp = AQ + (size_t)(b * 2048 + t0 + qo + r) * 1024 + head * 64 + quad * 8;
      const bf16x8 qf0 = *reinterpret_cast<const bf16x8*>(qp);
      const bf16x8 qf1 = *reinterpret_cast<const bf16x8*>(qp + 32);
      f32x4 s[18];
      s[17] = f32x4{0.f, 0.f, 0.f, 0.f};
#pragma unroll
      for (int kt = 0; kt < 17; ++kt) {
        const int row = qo + kt * 16 + r;
        const char* kp = lds + row * 128;
        const bf16x8 kf0 = *reinterpret_cast<const bf16x8*>(kp + (((0 + quad) ^ (row & 7)) << 4));
        const bf16x8 kf1 = *reinterpret_cast<const bf16x8*>(kp + (((4 + quad) ^ (row & 7)) << 4));
        f32x4 a = {0.f, 0.f, 0.f, 0.f};
        a = __builtin_amdgcn_mfma_f32_16x16x32_bf16(kf0, qf0, a, 0, 0, 0);
        a = __builtin_amdgcn_mfma_f32_16x16x32_bf16(kf1, qf1, a, 0, 0, 0);
        s[kt] = a;
      }
      float mx = sink2;
      if (INTERIOR) {
#pragma unroll
        for (int kt = 0; kt < 17; ++kt) {
#pragma unroll
          for (int j = 0; j < 4; ++j) {
            const float e = bd[j] - (float)(kt * 16);
            float sc = fmaf(-slope2, fabsf(e), s[kt][j]);
            if (kt == 0) sc = (e <= 128.0f) ? sc : -1e30f;
            if (kt == 16) sc = (e >= -128.0f) ? sc : -1e30f;
            s[kt][j] = sc;
            mx = fmaxf(mx, sc);
          }
        }
      } else {
        const float tqf = (float)(t0 + qo + r);
        const float hi = fminf(128.0f, tqf), lo = fmaxf(-128.0f, tqf - 2047.0f);
#pragma unroll
        for (int kt = 0; kt < 17; ++kt) {
#pragma unroll
          for (int j = 0; j < 4; ++j) {
            const float e = bd[j] - (float)(kt * 16);
            const float sc = (e <= hi && e >= lo) ? fmaf(-slope2, fabsf(e), s[kt][j]) : -1e30f;
            s[kt][j] = sc;
            mx = fmaxf(mx, sc);
          }
        }
      }
      mx = fmaxf(mx, __shfl_xor(mx, 16));
      mx = fmaxf(mx, __shfl_xor(mx, 32));
      float sum = 0.f;
#pragma unroll
      for (int kt = 0; kt < 17; ++kt) {
#pragma unroll
        for (int j = 0; j < 4; ++j) {
          const float pv = __builtin_amdgcn_exp2f(s[kt][j] - mx);
          s[kt][j] = pv;
          sum += pv;
        }
      }
      sum += __shfl_xor(sum, 16);
      sum += __shfl_xor(sum, 32);
      sum += __builtin_amdgcn_exp2f(sink2 - mx);
      const float inv = 1.0f / sum;
      f32x4 o[4];
#pragma unroll
      for (int dt = 0; dt < 4; ++dt) o[dt] = f32x4{0.f, 0.f, 0.f, 0.f};
#pragma unroll
      for (int st = 0; st < 9; ++st) {
        union { uint4 u; bf16x8 v; } pb;
        pb.u.x = pack2(s[2 * st][0], s[2 * st][1]);
        pb.u.y = pack2(s[2 * st][2], s[2 * st][3]);
        pb.u.z = pack2(s[2 * st + 1][0], s[2 * st + 1][1]);
        pb.u.w = pack2(s[2 * st + 1][2], s[2 * st + 1][3]);
        const int kl = qo + st * 32 + quad * 4;
#pragma unroll
        for (int dt = 0; dt < 4; ++dt) {
          const char* vp = lds + AT_VOFF + (dt * 16 + r) * AT_VPITCH + kl * 2;
          const uint2 xa = *reinterpret_cast<const uint2*>(vp);
          const uint2 xb2 = *reinterpret_cast<const uint2*>(vp + 32);
          union { uint4 u; bf16x8 v; } af;
          af.u.x = xa.x; af.u.y = xa.y; af.u.z = xb2.x; af.u.w = xb2.y;
          o[dt] = __builtin_amdgcn_mfma_f32_16x16x32_bf16(af.v, pb.v, o[dt], 0, 0, 0);
        }
      }
#pragma unroll
      for (int dt = 0; dt < 4; ++dt) {
        uint2 ov; ov.x = pack2(o[dt][0] * inv, o[dt][1] * inv); ov.y = pack2(o[dt][2] * inv, o[dt][3] * inv);
        *reinterpret_cast<uint2*>(AO + (size_t)(b * 2048 + t0 + qo + r) * 1024 + head * 64 + dt * 16 + quad * 4) = ov;
      }
}

__device__ __forceinline__ void attn_core(const Params& p, int layer, char* lds) {
  unsigned char* ws = opaque_ptr(p.ws);
  const bf16_t* AQ = reinterpret_cast<const bf16_t*>(ws + OFF_AQ);
  const bf16_t* AK = reinterpret_cast<const bf16_t*>(ws + OFF_AK);
  const bf16_t* AVT = reinterpret_cast<const bf16_t*>(ws + OFF_AVT);
  bf16_t* AO = reinterpret_cast<bf16_t*>(ws + OFF_AO);
  const int li = layer >> 1;
  const int tid = opaque_tid();
  const int lane = tid & 63, wid8 = tid >> 6, wid = wid8 & 3, r = lane & 15, quad = lane >> 4;
  for (int k4 = 0; k4 < 4; ++k4) {
    const int item = ((int)blockIdx.x & 7) * 128 + ((int)blockIdx.x >> 3) * 4 + k4;
    const int qb = item & 31, kvh = (item >> 5) & 3, b = item >> 7;
    const int t0 = qb * 64, ks = t0 - 128;
    __syncthreads();
#pragma unroll
    for (int i = 0; i < 5; ++i) {
      const int c = tid + i * 512;
      {
        const int row = c >> 3, kc = c & 7, key = ks + row;
        uint4 v = {0u, 0u, 0u, 0u};
        if (key >= 0 && key < 2048) v = *reinterpret_cast<const uint4*>(AK + (size_t)(b * 2048 + key) * 256 + kvh * 64 + kc * 8);
        *reinterpret_cast<uint4*>(lds + row * 128 + ((kc ^ (row & 7)) << 4)) = v;
      }
      {
        const int d = c / 40, kc = c - d * 40, key = ks + kc * 8;
        uint4 v = {0u, 0u, 0u, 0u};
        if (key >= 0 && key < 2048) v = *reinterpret_cast<const uint4*>(AVT + ((size_t)((b * 4 + kvh) * 64 + d)) * 2048 + key);
        *reinterpret_cast<uint4*>(lds + AT_VOFF + d * AT_VPITCH + kc * 16) = v;
      }
    }
    __syncthreads();
    const int head = kvh * 4 + wid;
    const float sink2 = p.sink[li * 16 + head] * LOG2E;
    const float slope2 = exp2f(-0.5f * (float)(head + 1)) * LOG2E;
    float bd[4];
#pragma unroll
    for (int j = 0; j < 4; ++j) bd[j] = (float)(r + 128 - quad * 4 - j);
#pragma unroll 1
    for (int jq = 0; jq < 2; ++jq) {
      const int qo = ((wid8 >> 2) * 2 + jq) * 16;
      if ((t0 >= 128) && (t0 + 192 <= 2048)) attn_qtile<true>(AQ, AO, lds, b, t0, qo, head, r, quad, sink2, slope2, bd);
      else                                  attn_qtile<false>(AQ, AO, lds, b, t0, qo, head, r, quad, sink2, slope2, bd);
    }
  }
}

template <int MODE>
__device__ __forceinline__ void big_gemm(char* lds, const bf16_t* A, const bf16_t* W, int M, int N, int K, bf16_t* C, int ldc, const float* rstd) {
  pg8::Sched2 S;
  S.A0 = (const char*)A; S.B0 = (const char*)W; S.A1 = S.A0; S.B1 = S.B0;
  S.nM0 = M / 256; S.nN0 = N / 256; S.nM1 = 0; S.nN1 = 0; S.G = (int)gridDim.x; S.c = (int)blockIdx.x; S.tstep = (size_t)256 * K * 2;
  pg8::EpiRows<MODE> E{C, ldc, rstd};
  pg8::gemm_phase(( PG8_LAS unsigned char*)lds, K, S, E);
}

template <bool PRE, bool FIN, bool SQ>
__device__ __forceinline__ void proj_resid(char* lds, unsigned char* ws, const bf16_t* A, const bf16_t* W, int K, const float* gpost, int inst, int set, float* out) {
  pg8::Sched2 S;
  S.A0 = (const char*)A; S.B0 = (const char*)W; S.A1 = S.A0; S.B1 = S.B0;
  S.nM0 = 64; S.nN0 = 4; S.nM1 = 0; S.nN1 = 0; S.G = (int)gridDim.x; S.c = (int)blockIdx.x; S.tstep = (size_t)256 * K * 2;
  pg8::EpiResid<PRE, FIN, SQ> E{ws, gpost, inst, set, out};
  pg8::gemm_phase((PG8_LAS unsigned char*)lds, K, S, E);
}

__global__ void __launch_bounds__(512, 2) fwd_megakernel(Params p, int never) {
  extern __shared__ __attribute__((aligned(16))) char lds[];
  volatile LAS unsigned* st = (volatile LAS unsigned*)(lds + LDS_STAGE);
  if (threadIdx.x == 0) { st[0] = 0u; st[1] = 0u; st[2] = 0u; st[3] = 0u; }
  __syncthreads();
  if (never == 0x7fffabcd) { cg::this_grid().sync(); }
    (void)xcd_barrier_post(reinterpret_cast<unsigned*>(p.ws + OFF_BAR), st);

  phase_init(p);
  convert_layer(p, 0, lds);
  xcd_barrier(XcdBarrier{reinterpret_cast<unsigned*>(p.ws + OFF_BAR), xb_xcc_id(), (volatile LAS unsigned*)(lds + LDS_STAGE)});

#pragma unroll 1
  for (int layer = 0; layer < 4; ++layer) {
    if ((layer & 1) == 0) {
      const int li = layer >> 1;
#define RET_QKV(qd_) do { \
          pg8::SchedRetQKV S; \
          S.A0 = (const char*)((reinterpret_cast<bf16_t*>(p.ws + OFF_XB)) + (size_t)(qd_) * 4096 * 1024); S.B0 = (const char*)(reinterpret_cast<const bf16_t*>(p.ws + OFF_WIN)); \
          S.A1 = (const char*)((reinterpret_cast<const bf16_t*>(p.ws + OFF_WIN)) + (size_t)1024 * 1024); S.B1 = S.A0; \
          S.tstep = (size_t)256 * 1024 * 2; S.xcd = (int)blockIdx.x & 7; S.slot = (int)blockIdx.x >> 3; \
          pg8::EpiRetQKV E{(p.ws), (qd_), p.ldf + li * 4, p.ldb + li * 4}; \
          pg8::gemm_phase((PG8_LAS unsigned char*)lds, 1024, S, E); } while (0)
      if (layer > 0) { convert_layer(p, layer, lds, 2); __syncthreads(); }
      RET_QKV(0);
      xcd_barrier(XcdBarrier{reinterpret_cast<unsigned*>(p.ws + OFF_BAR), xb_xcc_id(), (volatile LAS unsigned*)(lds + LDS_STAGE)});
#pragma unroll 1
      for (int qd = 0; qd < 4; ++qd) {
        if (blockIdx.x < 128) ret_states_chain(p, layer, qd, lds);
        else ret_states_gate(p, qd, lds);
        ret_states_s(p, layer, qd, lds);
        xcd_barrier(XcdBarrier{reinterpret_cast<unsigned*>(p.ws + OFF_BAR), xb_xcc_id(), (volatile LAS unsigned*)(lds + LDS_STAGE)});
        ret_output(p, layer, qd, lds);
        if (qd < 3) RET_QKV(qd + 1);
        xcd_barrier(XcdBarrier{reinterpret_cast<unsigned*>(p.ws + OFF_BAR), xb_xcc_id(), (volatile LAS unsigned*)(lds + LDS_STAGE)});
      }
#undef RET_QKV
      proj_resid<false, false, true>(lds, (p.ws), reinterpret_cast<const bf16_t*>((p.ws) + OFF_ABUF), (reinterpret_cast<const bf16_t*>(p.ws + OFF_WOUT)), 2048, p.g_post_mix + layer * 1024, layer, 0, nullptr);
      xcd_barrier(XcdBarrier{reinterpret_cast<unsigned*>(p.ws + OFF_BAR), xb_xcc_id(), (volatile LAS unsigned*)(lds + LDS_STAGE)});
    } else {
      if (blockIdx.x >= 128) { convert_layer(p, layer, lds, 2, 128, 128); __syncthreads(); }
      {
        pg8::Sched2 S;
        S.A0 = (const char*)(reinterpret_cast<bf16_t*>(p.ws + OFF_XB)); S.B0 = (const char*)(reinterpret_cast<const bf16_t*>(p.ws + OFF_WIN));
        S.A1 = (const char*)((reinterpret_cast<const bf16_t*>(p.ws + OFF_WIN)) + (size_t)1280 * 1024); S.B1 = (const char*)(reinterpret_cast<bf16_t*>(p.ws + OFF_XB));
        S.nM0 = 64; S.nN0 = 5; S.nM1 = 1; S.nN1 = 64; S.G = (int)gridDim.x; S.c = (int)blockIdx.x; S.tstep = (size_t)256 * 1024 * 2;
        pg8::EpiAttnIn E{(p.ws)};
        pg8::gemm_phase((PG8_LAS unsigned char*)lds, 1024, S, E);
      }
      xcd_barrier(XcdBarrier{reinterpret_cast<unsigned*>(p.ws + OFF_BAR), xb_xcc_id(), (volatile LAS unsigned*)(lds + LDS_STAGE)});
      attn_core(p, layer, lds);
      xcd_barrier(XcdBarrier{reinterpret_cast<unsigned*>(p.ws + OFF_BAR), xb_xcc_id(), (volatile LAS unsigned*)(lds + LDS_STAGE)});
      proj_resid<false, false, true>(lds, (p.ws), reinterpret_cast<const bf16_t*>((p.ws) + OFF_AO), (reinterpret_cast<const bf16_t*>(p.ws + OFF_WOUT)), 1024, p.g_post_mix + layer * 1024, layer, 0, nullptr);
      xcd_barrier(XcdBarrier{reinterpret_cast<unsigned*>(p.ws + OFF_BAR), xb_xcc_id(), (volatile LAS unsigned*)(lds + LDS_STAGE)});
    }
    if (layer < 3) { convert_layer(p, layer + 1, lds, 1); __syncthreads(); }
    big_gemm<3>(lds, (reinterpret_cast<bf16_t*>(p.ws + OFF_XB)), reinterpret_cast<const bf16_t*>((p.ws) + OFF_WUP), 16384, 4096, 1024, reinterpret_cast<bf16_t*>((p.ws) + OFF_HID), 4096, nullptr);
    xcd_barrier(XcdBarrier{reinterpret_cast<unsigned*>(p.ws + OFF_BAR), xb_xcc_id(), (volatile LAS unsigned*)(lds + LDS_STAGE)});
    if (layer < 3) {
      proj_resid<true, false, false>(lds, (p.ws), reinterpret_cast<const bf16_t*>((p.ws) + OFF_HID), reinterpret_cast<const bf16_t*>((p.ws) + OFF_WDN), 4096,
                                     p.g_post_mlp + layer * 1024, layer, 1, nullptr);
      xcd_barrier(XcdBarrier{reinterpret_cast<unsigned*>(p.ws + OFF_BAR), xb_xcc_id(), (volatile LAS unsigned*)(lds + LDS_STAGE)});
    } else {
      proj_resid<true, true, false>(lds, (p.ws), reinterpret_cast<const bf16_t*>((p.ws) + OFF_HID), reinterpret_cast<const bf16_t*>((p.ws) + OFF_WDN), 4096,
                                    p.g_post_mlp + layer * 1024, layer, 1, p.out);
    }
  }
}


extern "C" void kernel_launch(void* const* d_in, const int* in_sizes, int n_in, void* d_out, int out_size,
                              void* d_ws, size_t ws_size, hipStream_t stream) {
  static int grid_blocks = 0;
  if (!grid_blocks) {
    int dev = 0, cus = 0, per_cu = 0;
    (void)hipGetDevice(&dev);
    (void)hipDeviceGetAttribute(&cus, hipDeviceAttributeMultiprocessorCount, dev);
    (void)hipFuncSetAttribute((const void*)fwd_megakernel, hipFuncAttributeMaxDynamicSharedMemorySize, LDS_BYTES);
    (void)hipOccupancyMaxActiveBlocksPerMultiprocessor(&per_cu, (const void*)fwd_megakernel, 512, LDS_BYTES);
    if (per_cu < 1) fprintf(stderr, "kernel_launch: occupancy query reports %d blocks per CU\n", per_cu);
    grid_blocks = 256;
    if (cus < 256) fprintf(stderr, "kernel_launch: %d CUs < 256: the grid will not be co-resident\n", cus);
    if (ws_size < WS_NEED) fprintf(stderr, "kernel_launch: workspace too small: %zu < %zu\n", ws_size, (size_t)WS_NEED);
  }
  (void)hipMemsetAsync((char*)d_ws + OFF_BAR, 0, 16384, stream);
  (void)hipMemsetAsync((char*)d_ws + OFF_XFLAG, 0, 8192 + 16384, stream);
  Params p{};
  p.x = (const float*)d_in[0]; p.w_in_ret = (const float*)d_in[1]; p.w_out_ret = (const float*)d_in[2];
  p.ldf = (const float*)d_in[3]; p.ldb = (const float*)d_in[4]; p.w_in_attn = (const float*)d_in[5];
  p.w_out_attn = (const float*)d_in[6]; p.sink = (const float*)d_in[7]; p.g_pre_mix = (const float*)d_in[8];
  p.g_post_mix = (const float*)d_in[9]; p.g_pre_mlp = (const float*)d_in[10]; p.g_post_mlp = (const float*)d_in[11];
  p.w_up = (const float*)d_in[12]; p.w_down = (const float*)d_in[13];
  p.out = (float*)d_out; p.ws = (unsigned char*)d_ws;
  int never = 0;
  void* args[] = {&p, &never};
  hipError_t e = hipLaunchCooperativeKernel((const void*)fwd_megakernel, dim3(grid_blocks), dim3(512), args, LDS_BYTES, stream);
  if (e != hipSuccess) fprintf(stderr, "cooperative launch failed: %s (grid %d)\n", hipGetErrorString(e), grid_blocks);
}
```

```cpp
#include <hip/hip_runtime.h>
#include <hip/hip_cooperative_groups.h>
#include <stdint.h>
#include <stdio.h>
namespace cg = cooperative_groups;

typedef unsigned short bf16_t;
using bf16x8 = __attribute__((ext_vector_type(8))) short;
using f32x4  = __attribute__((ext_vector_type(4))) float;

constexpr int T_TOK = 16384, DM = 1024, SEQ = 2048;
constexpr float EPSV = 1e-6f;
constexpr float LOG2E = 1.4426950408889634f;

constexpr size_t OFF_BAR   = 0;
constexpr size_t OFF_WIN   = 16384;
constexpr size_t OFF_WOUT  = OFF_WIN  + 12582912;
constexpr size_t OFF_WUP   = OFF_WOUT + 4194304;
constexpr size_t OFF_WDN   = OFF_WUP  + 8388608;
constexpr size_t OFF_XB    = OFF_WDN  + 8388608;
constexpr size_t OFF_RSTD  = OFF_XB   + 33554432;
constexpr size_t OFF_OPART = OFF_RSTD + 65536;
constexpr size_t OFF_XFLAG = OFF_OPART;
constexpr size_t OFF_XCH   = OFF_OPART + 65536;
constexpr size_t OFF_XFLAG2 = OFF_OPART + 8192;
constexpr size_t OFF_XCH2  = OFF_OPART + 65536 + 131072;
constexpr size_t OFF_HB    = OFF_OPART + 4194304;
constexpr size_t OFF_M     = OFF_HB + 33554432;
constexpr size_t OFF_ABUF  = OFF_M;
constexpr size_t OFF_QQ    = OFF_ABUF + 67108864;
constexpr size_t OFF_KQ    = OFF_QQ  + 8388608;
constexpr size_t OFF_KFT   = OFF_KQ  + 8388608;
constexpr size_t OFF_KBT   = OFF_KFT + 8388608;
constexpr size_t OFF_VT    = OFF_KBT + 8388608;
constexpr size_t OFF_RQ    = OFF_VT  + 16777216;
constexpr size_t OFF_PQ    = OFF_RQ  + 29360128;
constexpr size_t OFF_END_R = OFF_PQ  + 8388608;
constexpr size_t OFF_AQ    = OFF_M;
constexpr size_t OFF_AK    = OFF_AQ + 33554432;
constexpr size_t OFF_AVT   = OFF_AK + 8388608;
constexpr size_t OFF_AO    = OFF_AVT + 8388608;
constexpr size_t OFF_HID   = OFF_M;
constexpr size_t WS_NEED   = OFF_END_R;
__device__ __forceinline__ size_t off_qq(int par) { return par ? OFF_HB : OFF_QQ; }
__device__ __forceinline__ size_t off_vt(int par) { return par ? OFF_HB + 8388608 : OFF_VT; }

constexpr int LDS_STAGE = 131072;
constexpr int LDS_BYTES = LDS_STAGE + 64;

struct Params {
  const float *x, *w_in_ret, *w_out_ret, *ldf, *ldb, *w_in_attn, *w_out_attn, *sink;
  const float *g_pre_mix, *g_post_mix, *g_pre_mlp, *g_post_mlp, *w_up, *w_down;
  float* out;
  unsigned char* ws;
};

__device__ __forceinline__ float bf2f(unsigned v) { return __uint_as_float(v << 16); }
__device__ __forceinline__ unsigned f2bf(float f) { unsigned u = __float_as_uint(f); u += 0x7fffu + ((u >> 16) & 1u); return u >> 16; }
typedef float f32x2_t __attribute__((ext_vector_type(2)));
typedef __bf16 bf16x2_t __attribute__((ext_vector_type(2)));
__device__ __forceinline__ unsigned pack2(float a, float b) { f32x2_t v = {a, b}; return __builtin_bit_cast(unsigned, __builtin_convertvector(v, bf16x2_t)); }
__device__ __forceinline__ int opaque_tid() { int t = (int)threadIdx.x; asm volatile("" : "+v"(t)); return t; }
__device__ __forceinline__ unsigned char* opaque_ptr(unsigned char* p) { size_t z = 0; asm volatile("" : "+s"(z)); return p + z; }
__device__ __forceinline__ float wave_sum(float v) {
#pragma unroll
  for (int o = 32; o >= 1; o >>= 1) v += __shfl_xor(v, o);
  return v;
}

#define XB_TMO      128
#define XB_XCNT(j)  (256  + 64 * (j))
#define XB_XSUB(j)  (1280 + 64 * (j))
#define XB_XGEN(j)  (2304 + 64 * (j))
#define XB_TOP      3328
#define XB_TOPGEN   3392
#define XCD_BAR_WORDS 3456
#define XB_SPIN_CAP (1u << 22)
#define LAS __attribute__((address_space(3)))

__device__ __forceinline__ unsigned xb_ld(unsigned* p)              { return __hip_atomic_load(p, __ATOMIC_RELAXED, __HIP_MEMORY_SCOPE_AGENT); }
__device__ __forceinline__ unsigned xb_add(unsigned* p, unsigned v) { return __hip_atomic_fetch_add(p, v, __ATOMIC_RELAXED, __HIP_MEMORY_SCOPE_AGENT); }
__device__ __forceinline__ unsigned xb_xcc_id() { return (unsigned)__builtin_amdgcn_s_getreg((3 << 11) | 20) & 0xFu; }
#define XB_SPIN(cond, bar) do { unsigned _sp = 0; while (cond) { __builtin_amdgcn_s_sleep(1); \
    if ((++_sp & 255u) == 0u) { if (xb_ld(&(bar)[XB_TMO])) break; if (_sp > XB_SPIN_CAP) { atomicAdd(&(bar)[XB_TMO], 1u); break; } } } } while (0)

struct XcdBarrier { unsigned* bar; unsigned x; volatile LAS unsigned* st; };

__device__ __forceinline__ XcdBarrier xcd_barrier_post(unsigned* bar, volatile LAS unsigned* st) {
  XcdBarrier b; b.bar = bar; b.x = xb_xcc_id(); b.st = st;
  if (threadIdx.x == 0) (void)xb_add(&bar[XB_XCNT(b.x)], 1u);
  return b;
}
__device__ __forceinline__ void xcd_barrier_complete(unsigned* bar, unsigned x, unsigned& nloc, unsigned& nx) {
  const unsigned G = gridDim.x * gridDim.y * gridDim.z;
  unsigned sum, cnt, mine, sp = 0u;
  for (;;) {
    sum = 0u; cnt = 0u; mine = 0u;
#pragma unroll
    for (unsigned j = 0; j < 16; ++j) { const unsigned c = xb_ld(&bar[XB_XCNT(j)]); sum += c; cnt += (c > 0u) ? 1u : 0u; mine = (j == x) ? c : mine; }
    if (sum == G) break;
    __builtin_amdgcn_s_sleep(1);
    if ((++sp & 255u) == 0u) { if (xb_ld(&bar[XB_TMO])) break; if (sp > XB_SPIN_CAP) { atomicAdd(&bar[XB_TMO], 1u); break; } }
  }
  nloc = mine > 0u ? mine : 1u; nx = cnt > 0u ? cnt : 1u;
}
__device__ __forceinline__ void xcd_barrier(const XcdBarrier& b) {
  asm volatile("s_waitcnt vmcnt(0)" ::: "memory");
  __syncthreads();
  if (threadIdx.x == 0) {
    unsigned* bar = b.bar;
    __builtin_amdgcn_s_waitcnt(0);
    unsigned nloc = b.st[0], nx = b.st[1];
    if (nloc == 0u) { xcd_barrier_complete(bar, b.x, nloc, nx); b.st[0] = nloc; b.st[1] = nx; }
    const unsigned old = xb_add(&bar[XB_XSUB(b.x)], 1u);
    const unsigned gen = old / nloc;
    if (old + 1u == (gen + 1u) * nloc) {
      __builtin_amdgcn_fence(__ATOMIC_RELEASE, "agent");
      asm volatile("s_waitcnt vmcnt(0)" ::: "memory");
      const unsigned og = xb_add(&bar[XB_TOP], 1u);
      const unsigned tg = og / nx;
      if (og + 1u == (tg + 1u) * nx) xb_add(&bar[XB_TOPGEN], 1u);
      else XB_SPIN(xb_ld(&bar[XB_TOPGEN]) == tg, bar);
      __builtin_amdgcn_fence(__ATOMIC_ACQUIRE, "agent");
      xb_add(&bar[XB_XGEN(b.x)], 1u);
      asm volatile("s_waitcnt vmcnt(0)" ::: "memory");
    } else {
      XB_SPIN(xb_ld(&bar[XB_XGEN(b.x)]) == gen, bar);
      __builtin_amdgcn_fence(__ATOMIC_ACQUIRE, "agent");
      asm volatile("s_waitcnt vmcnt(0)" ::: "memory");
    }
  }
  __syncthreads();
}

template <bool SWAP>
__device__ __forceinline__ void gemm_acc(f32x4 (&acc)[4][4], const bf16_t* __restrict__ A, int lda,
                                         const bf16_t* __restrict__ B, int ldb, int K, char* lds, const int tid) {
  const int lane = tid & 63, wid = tid >> 6;
  const int wm = wid >> 1, wn = wid & 1;
  const int r = lane & 15, quad = lane >> 4;
  const int lrow = tid >> 3, lkc = tid & 7;
  const bf16_t* Ag = A + (size_t)lrow * lda + lkc * 8;
  const bf16_t* Bg = B + (size_t)lrow * ldb + lkc * 8;
  const int wofs = lrow * 128 + ((lkc ^ (lrow & 7)) << 4);
  const int aofs = (wm * 64 + r) * 128;
  const int bofs = 16384 + (wn * 64 + r) * 128;
  const int sw = r & 7;
  uint4 ra0, ra1, ra2, ra3, rb0, rb1, rb2, rb3;
  const int nk = K >> 6;
#define G_LOAD(k0) do { \
    ra0 = *reinterpret_cast<const uint4*>(Ag + (k0));                       rb0 = *reinterpret_cast<const uint4*>(Bg + (k0)); \
    ra1 = *reinterpret_cast<const uint4*>(Ag + (size_t)32 * lda + (k0));    rb1 = *reinterpret_cast<const uint4*>(Bg + (size_t)32 * ldb + (k0)); \
    ra2 = *reinterpret_cast<const uint4*>(Ag + (size_t)64 * lda + (k0));    rb2 = *reinterpret_cast<const uint4*>(Bg + (size_t)64 * ldb + (k0)); \
    ra3 = *reinterpret_cast<const uint4*>(Ag + (size_t)96 * lda + (k0));    rb3 = *reinterpret_cast<const uint4*>(Bg + (size_t)96 * ldb + (k0)); } while (0)
#define G_STORE(buf) do { char* _d = (buf) + wofs; \
    *reinterpret_cast<uint4*>(_d) = ra0;          *reinterpret_cast<uint4*>(_d + 16384) = rb0; \
    *reinterpret_cast<uint4*>(_d + 4096) = ra1;   *reinterpret_cast<uint4*>(_d + 16384 + 4096) = rb1; \
    *reinterpret_cast<uint4*>(_d + 8192) = ra2;   *reinterpret_cast<uint4*>(_d + 16384 + 8192) = rb2; \
    *reinterpret_cast<uint4*>(_d + 12288) = ra3;  *reinterpret_cast<uint4*>(_d + 16384 + 12288) = rb3; } while (0)
#define G_COMPUTE(cur) do { \
    _Pragma("unroll") for (int ks = 0; ks < 2; ++ks) { \
      bf16x8 af0, af1, af2, af3, bf0, bf1, bf2, bf3; \
      const int co = ((ks * 4 + quad) ^ sw) << 4; \
      af0 = *reinterpret_cast<const bf16x8*>((cur) + aofs + co);        bf0 = *reinterpret_cast<const bf16x8*>((cur) + bofs + co); \
      af1 = *reinterpret_cast<const bf16x8*>((cur) + aofs + 2048 + co); bf1 = *reinterpret_cast<const bf16x8*>((cur) + bofs + 2048 + co); \
      af2 = *reinterpret_cast<const bf16x8*>((cur) + aofs + 4096 + co); bf2 = *reinterpret_cast<const bf16x8*>((cur) + bofs + 4096 + co); \
      af3 = *reinterpret_cast<const bf16x8*>((cur) + aofs + 6144 + co); bf3 = *reinterpret_cast<const bf16x8*>((cur) + bofs + 6144 + co); \
      G_MMA(0, 0, af0, bf0); G_MMA(0, 1, af0, bf1); G_MMA(0, 2, af0, bf2); G_MMA(0, 3, af0, bf3); \
      G_MMA(1, 0, af1, bf0); G_MMA(1, 1, af1, bf1); G_MMA(1, 2, af1, bf2); G_MMA(1, 3, af1, bf3); \
      G_MMA(2, 0, af2, bf0); G_MMA(2, 1, af2, bf1); G_MMA(2, 2, af2, bf2); G_MMA(2, 3, af2, bf3); \
      G_MMA(3, 0, af3, bf0); G_MMA(3, 1, af3, bf1); G_MMA(3, 2, af3, bf2); G_MMA(3, 3, af3, bf3); \
    } } while (0)
#define G_MMA(ms, ns, a, b) acc[ms][ns] = SWAP ? __builtin_amdgcn_mfma_f32_16x16x32_bf16(b, a, acc[ms][ns], 0, 0, 0) \
                                               : __builtin_amdgcn_mfma_f32_16x16x32_bf16(a, b, acc[ms][ns], 0, 0, 0)
  G_LOAD(0);
  __syncthreads();
  G_STORE(lds);
  __syncthreads();
  for (int kt = 0; kt < nk - 1; ++kt) {
    char* cur = lds + (kt & 1) * 32768;
    char* nxt = lds + ((kt + 1) & 1) * 32768;
    const int k0 = (kt + 1) * 64;
    G_LOAD(k0);
    G_COMPUTE(cur);
    G_STORE(nxt);
    __syncthreads();
  }
  {
    char* cur = lds + ((nk - 1) & 1) * 32768;
    G_COMPUTE(cur);
    __syncthreads();
  }
#undef G_LOAD
#undef G_STORE
#undef G_COMPUTE
#undef G_MMA
}


__device__ __forceinline__ void store_tile_plain(const f32x4 (&acc)[4][4], bf16_t* dst, int ld, const int tid) {
  const int lane = tid & 63, wid = tid >> 6, wm = wid >> 1, wn = wid & 1, r = lane & 15, quad = lane >> 4;
#pragma unroll
  for (int ms = 0; ms < 4; ++ms) {
    const int m = wm * 64 + ms * 16 + r;
#pragma unroll
    for (int ns = 0; ns < 4; ++ns) {
      const int n0 = wn * 64 + ns * 16 + quad * 4;
      const f32x4 v = acc[ms][ns];
      uint2 o; o.x = pack2(v[0], v[1]); o.y = pack2(v[2], v[3]);
      *reinterpret_cast<uint2*>(dst + (size_t)m * ld + n0) = o;
    }
  }
}

__device__ __forceinline__ void store_tile8(const f32x4 (&acc)[4][2], bf16_t* dst, int ld, const int tid) {
  const int lane = tid & 63, wid = tid >> 6, wm = wid >> 2, wn = wid & 3, r = lane & 15, quad = lane >> 4;
#pragma unroll
  for (int ms = 0; ms < 4; ++ms) {
    const int m = wm * 64 + ms * 16 + r;
#pragma unroll
    for (int ns = 0; ns < 2; ++ns) {
      const int n0 = wn * 32 + ns * 16 + quad * 4;
      const f32x4 v = acc[ms][ns];
      uint2 o; o.x = pack2(v[0], v[1]); o.y = pack2(v[2], v[3]);
      *reinterpret_cast<uint2*>(dst + (size_t)m * ld + n0) = o;
    }
  }
}
template <int MODE>
__device__ __forceinline__ void gm_ptrs(int g, const bf16_t* P0, const bf16_t* P1, const bf16_t* P2, const bf16_t* P3, const bf16_t* P4, int i0,
                                        const bf16_t*& A, int& lda, const bf16_t*& B, int& ldb) {
  if (MODE == 2) {
    A = P0 + g * 64; B = P1 + g * 64; lda = i0 & 0xffff; ldb = i0 >> 16;
  } else if (MODE == 0) {
    const int s = g >> 2, c = i0 ? 7 - s : s, ko = c * 256 + (g & 3) * 64;
    A = P0 + c * 32768 + (g & 3) * 64; B = P1 + c * 32768 + (g & 3) * 64; lda = 256; ldb = 256;
  } else {
    const int s = g >> 2, ty = (i0 == 0) ? s + 1 : ((i0 == 7) ? (s == 0 ? 0 : 2) : s), ko = (g & 3) * 64;
    const bool pv = (ty == 2);
    A = (pv ? P3 : P0) + ko; lda = pv ? 256 : 1024;
    const bf16_t* bsel = (ty == 0) ? P1 : P2;
    B = (pv ? P4 : bsel) + ko; ldb = 256;
  }
}
template <int MODE>
__device__ __forceinline__ void gemm8(f32x4 (&acc)[4][2], const int nsteps, const bf16_t* P0, const bf16_t* P1, const bf16_t* P2, const bf16_t* P3,
                                      const bf16_t* P4, const int i0, const float s0, const float s1, const float s2, const float s3,
                                      const float s4, const float s5, const float s6, const float s7, char* lds, const int tid) {
  const int lane = tid & 63, wid = tid >> 6;
  const int wm = wid >> 2, wn = wid & 3;
  const int r = lane & 15, quad = lane >> 4;
  const int lrow = tid >> 3, lkc = tid & 7;
  const int wofs = lrow * 128 + ((lkc ^ (lrow & 7)) << 4);
  const int aofs = (wm * 64 + r) * 128;
  const int bofs = 16384 + (wn * 32 + r) * 128;
  const int sw = r & 7;
  uint4 xa0, xa1, xb0, xb1, ya0, ya1, yb0, yb1, za0, za1, zb0, zb1, wa0, wa1, wb0, wb1;
#define GM_LOAD(g, S) do { const bf16_t* _Ap; const bf16_t* _Bp; int _lda, _ldb; gm_ptrs<MODE>((g), P0, P1, P2, P3, P4, i0, _Ap, _lda, _Bp, _ldb); \
    const bf16_t* _a = _Ap + (size_t)lrow * _lda + lkc * 8; const bf16_t* _b = _Bp + (size_t)lrow * _ldb + lkc * 8; \
    S##a0 = *reinterpret_cast<const uint4*>(_a);                       S##b0 = *reinterpret_cast<const uint4*>(_b); \
    S##a1 = *reinterpret_cast<const uint4*>(_a + (size_t)64 * _lda);   S##b1 = *reinterpret_cast<const uint4*>(_b + (size_t)64 * _ldb); } while (0)
#define GM_STORE(buf, S) do { char* _d = (buf) + wofs; \
    *reinterpret_cast<uint4*>(_d) = S##a0;          *reinterpret_cast<uint4*>(_d + 16384) = S##b0; \
    *reinterpret_cast<uint4*>(_d + 8192) = S##a1;   *reinterpret_cast<uint4*>(_d + 16384 + 8192) = S##b1; } while (0)
#define GM_MMA(ms, ns, a, b) acc[ms][ns] = __builtin_amdgcn_mfma_f32_16x16x32_bf16(b, a, acc[ms][ns], 0, 0, 0)
#define GM_COMPUTE(cur) do { \
    bf16x8 a00, a01, a02, a03, b00, b01, a10, a11, a12, a13, b10, b11; \
    const int co0 = ((0 + quad) ^ sw) << 4, co1 = ((4 + quad) ^ sw) << 4; \
    a00 = *reinterpret_cast<const bf16x8*>((cur) + aofs + co0);        b00 = *reinterpret_cast<const bf16x8*>((cur) + bofs + co0); \
    a01 = *reinterpret_cast<const bf16x8*>((cur) + aofs + 2048 + co0); b01 = *reinterpret_cast<const bf16x8*>((cur) + bofs + 2048 + co0); \
    a02 = *reinterpret_cast<const bf16x8*>((cur) + aofs + 4096 + co0); \
    a03 = *reinterpret_cast<const bf16x8*>((cur) + aofs + 6144 + co0); \
    a10 = *reinterpret_cast<const bf16x8*>((cur) + aofs + co1);        b10 = *reinterpret_cast<const bf16x8*>((cur) + bofs + co1); \
    a11 = *reinterpret_cast<const bf16x8*>((cur) + aofs + 2048 + co1); b11 = *reinterpret_cast<const bf16x8*>((cur) + bofs + 2048 + co1); \
    a12 = *reinterpret_cast<const bf16x8*>((cur) + aofs + 4096 + co1); \
    a13 = *reinterpret_cast<const bf16x8*>((cur) + aofs + 6144 + co1); \
    __builtin_amdgcn_sched_barrier(0); \
    __builtin_amdgcn_s_setprio(1); \
    GM_MMA(0, 0, a00, b00); GM_MMA(0, 1, a00, b01); GM_MMA(1, 0, a01, b00); GM_MMA(1, 1, a01, b01); \
    GM_MMA(2, 0, a02, b00); GM_MMA(2, 1, a02, b01); GM_MMA(3, 0, a03, b00); GM_MMA(3, 1, a03, b01); \
    GM_MMA(0, 0, a10, b10); GM_MMA(0, 1, a10, b11); GM_MMA(1, 0, a11, b10); GM_MMA(1, 1, a11, b11); \
    GM_MMA(2, 0, a12, b10); GM_MMA(2, 1, a12, b11); GM_MMA(3, 0, a13, b10); GM_MMA(3, 1, a13, b11); \
    __builtin_amdgcn_s_setprio(0); \
    __builtin_amdgcn_sched_barrier(0); \
  } while (0)
#define GM_PRE(g) do { if (MODE == 0 && ((g) & 3) == 0 && (g) > 0) { \
      _Pragma("unroll") for (int ms = 0; ms < 4; ++ms) _Pragma("unroll") for (int ns = 0; ns < 2; ++ns) acc[ms][ns] *= s0; } } while (0)
#define GM_POST(g) do { if (((g) & 3) == 3) { \
      if (MODE == 0) { const int _s = (g) >> 2, _c = i0 ? 7 - _s : _s, _slot = i0 ? _c - 1 : _c; \
        store_tile8(acc, const_cast<bf16_t*>(P2) + (size_t)_slot * 512 * 256, 256, tid); } \
      else if (MODE == 1) { const int _s = (g) >> 2, _ty = (i0 == 0) ? _s + 1 : ((i0 == 7) ? (_s == 0 ? 0 : 2) : _s); \
        if (_ty == 0) { _Pragma("unroll") for (int ns = 0; ns < 2; ++ns) { acc[0][ns] *= s0; acc[1][ns] *= s1; acc[2][ns] *= s2; acc[3][ns] *= s3; } } \
        else if (_ty == 1) { _Pragma("unroll") for (int ns = 0; ns < 2; ++ns) { acc[0][ns] *= s4; acc[1][ns] *= s5; acc[2][ns] *= s6; acc[3][ns] *= s7; } } } } } while (0)
  char* b0 = lds;
  char* b1 = lds + 32768;
  GM_LOAD(0, x); GM_LOAD(1, y); GM_LOAD(2, z); GM_LOAD(3, w);
  __syncthreads();
  GM_STORE(b0, x);
  __syncthreads();
  for (int g = 0; g < nsteps; g += 4) {
    const bool more = (g + 4 < nsteps);
    if (more) GM_LOAD(g + 4, x);
    GM_PRE(g);     GM_COMPUTE(b0); GM_POST(g);     GM_STORE(b1, y); __syncthreads();
    if (more) GM_LOAD(g + 5, y);
    GM_PRE(g + 1); GM_COMPUTE(b1); GM_POST(g + 1); GM_STORE(b0, z); __syncthreads();
    if (more) GM_LOAD(g + 6, z);
    GM_PRE(g + 2); GM_COMPUTE(b0); GM_POST(g + 2); GM_STORE(b1, w); __syncthreads();
    if (more) GM_LOAD(g + 7, w);
    GM_PRE(g + 3); GM_COMPUTE(b1); GM_POST(g + 3); if (more) GM_STORE(b0, x); __syncthreads();
  }
#undef GM_PRE
#undef GM_POST
#undef GM_LOAD
#undef GM_STORE
#undef GM_COMPUTE
#undef GM_MMA
}

__device__ __forceinline__ void gemm8w(f32x4 (&acc)[4][4], const int nsteps, const bf16_t* Aq, const bf16_t* Rf, const bf16_t* Rb, const bf16_t* Pp,
                                       const bf16_t* V0, const bf16_t* V1, const int c, const float s0, const float s1, const float s2, const float s3,
                                       const float s4, const float s5, const float s6, const float s7, char* lds, const int tid) {
  const int lane = tid & 63, wid = tid >> 6;
  const int wm = wid >> 2, wn = wid & 3;
  const int r = lane & 15, quad = lane >> 4;
  const int lrow = tid >> 3, lkc = tid & 7;
  const int wofs = lrow * 128 + ((lkc ^ (lrow & 7)) << 4);
  const int aofs = (wm * 64 + r) * 128;
  const int bofs = 16384 + (wn * 64 + r) * 128;
  const int sw = r & 7;
  uint4 xa0, xa1, xb0, xb1, xb2, xb3, ya0, ya1, yb0, yb1, yb2, yb3;
#define GW_TYPE(g) ((c == 0) ? ((g) >> 2) + 1 : ((c == 7) ? ((((g) >> 2) == 0) ? 0 : 2) : ((g) >> 2)))
#define GW_LOAD(g, S) do { const int _ty = GW_TYPE(g), _ko = ((g) & 3) * 64; const bool _pv = (_ty == 2); \
    const bf16_t* _a = (_pv ? Pp : Aq) + (size_t)lrow * (_pv ? 256 : 1024) + lkc * 8 + _ko; const size_t _a64 = (size_t)64 * (_pv ? 256 : 1024); \
    const bf16_t* _bs = (_ty == 0) ? Rf : Rb; \
    const bf16_t* _lo = (_pv ? V0 : _bs) + (size_t)lrow * 256 + lkc * 8 + _ko; \
    const bf16_t* _hi = (_pv ? V1 : _bs + 128 * 256) + (size_t)lrow * 256 + lkc * 8 + _ko; \
    S##a0 = *reinterpret_cast<const uint4*>(_a);        S##a1 = *reinterpret_cast<const uint4*>(_a + _a64); \
    S##b0 = *reinterpret_cast<const uint4*>(_lo);       S##b1 = *reinterpret_cast<const uint4*>(_lo + 64 * 256); \
    S##b2 = *reinterpret_cast<const uint4*>(_hi);       S##b3 = *reinterpret_cast<const uint4*>(_hi + 64 * 256); } while (0)
#define GW_STORE(buf, S) do { char* _d = (buf) + wofs; \
    *reinterpret_cast<uint4*>(_d) = S##a0;                  *reinterpret_cast<uint4*>(_d + 8192) = S##a1; \
    *reinterpret_cast<uint4*>(_d + 16384) = S##b0;          *reinterpret_cast<uint4*>(_d + 16384 + 8192) = S##b1; \
    *reinterpret_cast<uint4*>(_d + 16384 + 16384) = S##b2;  *reinterpret_cast<uint4*>(_d + 16384 + 24576) = S##b3; } while (0)
#define GW_MMA(ms, ns, a, b) acc[ms][ns] = __builtin_amdgcn_mfma_f32_16x16x32_bf16(b, a, acc[ms][ns], 0, 0, 0)
#define GW_COMPUTE(cur) do { \
    _Pragma("unroll") for (int ks = 0; ks < 2; ++ks) { \
      bf16x8 af0, af1, af2, af3, bf0, bf1, bf2, bf3; \
      const int co = ((ks * 4 + quad) ^ sw) << 4; \
      af0 = *reinterpret_cast<const bf16x8*>((cur) + aofs + co);        bf0 = *reinterpret_cast<const bf16x8*>((cur) + bofs + co); \
      af1 = *reinterpret_cast<const bf16x8*>((cur) + aofs + 2048 + co); bf1 = *reinterpret_cast<const bf16x8*>((cur) + bofs + 2048 + co); \
      af2 = *reinterpret_cast<const bf16x8*>((cur) + aofs + 4096 + co); bf2 = *reinterpret_cast<const bf16x8*>((cur) + bofs + 4096 + co); \
      af3 = *reinterpret_cast<const bf16x8*>((cur) + aofs + 6144 + co); bf3 = *reinterpret_cast<const bf16x8*>((cur) + bofs + 6144 + co); \
      __builtin_amdgcn_sched_barrier(0); \
      __builtin_amdgcn_s_setprio(1); \
      GW_MMA(0, 0, af0, bf0); GW_MMA(0, 1, af0, bf1); GW_MMA(0, 2, af0, bf2); GW_MMA(0, 3, af0, bf3); \
      GW_MMA(1, 0, af1, bf0); GW_MMA(1, 1, af1, bf1); GW_MMA(1, 2, af1, bf2); GW_MMA(1, 3, af1, bf3); \
      GW_MMA(2, 0, af2, bf0); GW_MMA(2, 1, af2, bf1); GW_MMA(2, 2, af2, bf2); GW_MMA(2, 3, af2, bf3); \
      GW_MMA(3, 0, af3, bf0); GW_MMA(3, 1, af3, bf1); GW_MMA(3, 2, af3, bf2); GW_MMA(3, 3, af3, bf3); \
      __builtin_amdgcn_s_setprio(0); \
      __builtin_amdgcn_sched_barrier(0); \
    } } while (0)
#define GW_POST(g) do { if (((g) & 3) == 3) { const int _ty = GW_TYPE(g); \
      if (_ty == 0) { _Pragma("unroll") for (int ns = 0; ns < 4; ++ns) { acc[0][ns] *= s0; acc[1][ns] *= s1; acc[2][ns] *= s2; acc[3][ns] *= s3; } } \
      else if (_ty == 1) { _Pragma("unroll") for (int ns = 0; ns < 4; ++ns) { acc[0][ns] *= s4; acc[1][ns] *= s5; acc[2][ns] *= s6; acc[3][ns] *= s7; } } } } while (0)
  char* b0 = lds;
  char* b1 = lds + 49152;
  GW_LOAD(0, x); GW_LOAD(1, y);
  __syncthreads();
  GW_STORE(b0, x);
  __syncthreads();
  for (int g = 0; g < nsteps; g += 2) {
    const bool more = (g + 2 < nsteps);
    if (more) GW_LOAD(g + 2, x);
    GW_COMPUTE(b0); GW_POST(g);     GW_STORE(b1, y); __syncthreads();
    if (more) GW_LOAD(g + 3, y);
    GW_COMPUTE(b1); GW_POST(g + 1); if (more) GW_STORE(b0, x); __syncthreads();
  }
#undef GW_TYPE
#undef GW_LOAD
#undef GW_STORE
#undef GW_MMA
#undef GW_COMPUTE
#undef GW_POST
}

__device__ __forceinline__ void zero_acc(f32x4 (&acc)[4][4]) {
#pragma unroll
  for (int ms = 0; ms < 4; ++ms)
#pragma unroll
    for (int ns = 0; ns < 4; ++ns) acc[ms][ns] = f32x4{0.f, 0.f, 0.f, 0.f};
}

__device__ __forceinline__ void store_tile_swap(const f32x4 (&acc)[4][4], bf16_t* dst, int ld, const float (&rs)[4], const int tid) {
  const int lane = tid & 63, wid = tid >> 6, wm = wid >> 1, wn = wid & 1, r = lane & 15, quad = lane >> 4;
#pragma unroll
  for (int ms = 0; ms < 4; ++ms) {
    const int m = wm * 64 + ms * 16 + r;
#pragma unroll
    for (int ns = 0; ns < 4; ++ns) {
      const int n0 = wn * 64 + ns * 16 + quad * 4;
      const f32x4 v = acc[ms][ns];
      uint2 o; o.x = pack2(v[0] * rs[ms], v[1] * rs[ms]); o.y = pack2(v[2] * rs[ms], v[3] * rs[ms]);
      *reinterpret_cast<uint2*>(dst + (size_t)m * ld + n0) = o;
    }
  }
}


namespace pg8 {
#define PG8_LAS __attribute__((address_space(3)))
typedef unsigned u32x4 __attribute__((ext_vector_type(4)));
constexpr int BM = 256, BK = 64, HALF = 128, HTB = HALF * BK * 2, NXCD = 8, WGM = 8;
__device__ __forceinline__ int lds_byte(int r, int c) { const int st = (r >> 4) * 2 + (c >> 5), rr = r & 15, cc = c & 31, ob = rr * 64 + cc * 2; return st * 1024 + (ob ^ (((ob >> 9) & 1) << 5)); }
__device__ __forceinline__ void stage_rc(int b, int& R, int& C) { const int st = b / 1024, sb = b % 1024, swz = sb ^ (((sb >> 9) & 1) << 5); R = (st >> 1) * 16 + swz / 64; C = (st & 1) * 32 + (swz % 64) / 2; }
__device__ __forceinline__ int perm32(int rho) { const int n = rho >> 4, i = rho & 15; return 8 * (i >> 2) + 4 * n + (i & 3); }
struct Unit { int pm, pn, kind; };
__device__ __forceinline__ unsigned cvt_pk_bf16(float lo, float hi) { unsigned r; asm volatile("s_nop 1\n\tv_cvt_pk_bf16_f32 %0, %1, %2" : "=v"(r) : "v"(lo), "v"(hi)); return r; }

__device__ __forceinline__ void decode_tile(int wgid, int nM, int nN, int& pm, int& pn) {
  const int nwg = nM * nN;
  { const int q = nwg / NXCD, r = nwg % NXCD, xcd = wgid % NXCD, off = wgid / NXCD; wgid = (xcd < r ? xcd * (q + 1) : r * (q + 1) + (xcd - r) * q) + off; }
  const int nig = WGM * nN, gid = wgid / nig, fm = gid * WGM, gsz = (nM - fm) < WGM ? (nM - fm) : WGM;
  pm = fm + ((wgid % nig) % gsz); pn = (wgid % nig) / gsz;
}
struct Sched2 {
  const char *A0, *B0, *A1, *B1; int nM0, nN0, nM1, nN1, G, c; size_t tstep;
  __device__ __forceinline__ bool next(int i, Unit& u) const {
    int L = i * G + c; const int n0 = nM0 * nN0, n1 = nM1 * nN1;
    if (L < n0) { u.kind = 0; decode_tile(L, nM0, nN0, u.pm, u.pn); return true; }
    L -= n0;
    if (L < n1) { u.kind = 1; decode_tile(L, nM1, nN1, u.pm, u.pn); return true; }
    return false;
  }
  __device__ __forceinline__ const char* aptr(const Unit& u) const { return (u.kind ? A1 : A0) + (size_t)u.pm * tstep; }
  __device__ __forceinline__ const char* bptr(const Unit& u) const { return (u.kind ? B1 : B0) + (size_t)u.pn * tstep; }
};

struct SchedRetQKV {
  const char *A0, *B0, *A1, *B1; size_t tstep; int xcd, slot;
  __device__ __forceinline__ bool next(int i, Unit& u) const {
    if (i != 0) return false;
    if (slot < 8) { u.kind = 0; u.pm = 2 * xcd + (slot >> 2); u.pn = slot & 3; }
    else { const int idx = slot - 8; u.kind = 1; u.pm = idx % 12; u.pn = 2 * xcd + idx / 12; }
    return true;
  }
  __device__ __forceinline__ const char* aptr(const Unit& u) const { return (u.kind ? A1 : A0) + (size_t)u.pm * tstep; }
  __device__ __forceinline__ const char* bptr(const Unit& u) const { return (u.kind ? B1 : B0) + (size_t)u.pn * tstep; }
};

template <class Epi, class Sched>
__device__ __forceinline__ void gemm_phase(PG8_LAS unsigned char* lds, const int K, const Sched& S, const Epi& E) {
    const int tid = opaque_tid(), wid = __builtin_amdgcn_readfirstlane(tid >> 6), lane = tid & 63, wr = wid >> 2, wc = wid & 3, fr = lane & 15, fq = lane >> 4;
    const int nt = K / BK;
    unsigned voffA[2], voffB[2];
#pragma unroll
    for (int i = 0; i < 2; ++i) { int R, C; stage_rc(tid * 16 + i * 8192, R, C); const int Rb = ((R & ~31) + perm32(R & 31));
        voffA[i] = (unsigned)(R * K + C) * 2u; voffB[i] = (unsigned)(Rb * K + C) * 2u; }
    const size_t kstep = (size_t)(BK * 2);
    const size_t hstep = (size_t)HALF * K * 2;
    const unsigned ldsw = (unsigned)wid * 1024u;
    const int aoff = lds_byte(wr * 64 + fr, fq * 8), boff = lds_byte(wc * 32 + fr, fq * 8);
#define PG8_SA(b, h) (((b) * 2 + (h)) * HTB)
#define PG8_SB(b, h) ((4 + (b) * 2 + (h)) * HTB)
#define PG8_STAGE(bufoff, gbase, voff) do { _Pragma("unroll") for (int _i = 0; _i < 2; ++_i) \
        __builtin_amdgcn_global_load_lds((const unsigned*)((const char*)(gbase) + (voff)[_i]), (PG8_LAS unsigned*)(lds + (bufoff) + ldsw + _i * 8192), 16, 0, 0); } while (0)
#define PG8_LDA(dst, b, h) do { _Pragma("unroll") for (int m = 0; m < 4; ++m) _Pragma("unroll") for (int k = 0; k < 2; ++k) dst[m][k] = *(const PG8_LAS bf16x8*)(lds + PG8_SA(b, h) + aoff + m * 2048 + k * 1024); } while (0)
#define PG8_LDB(dst, b, h) do { _Pragma("unroll") for (int n = 0; n < 2; ++n) _Pragma("unroll") for (int k = 0; k < 2; ++k) dst[n][k] = *(const PG8_LAS bf16x8*)(lds + PG8_SB(b, h) + boff + n * 2048 + k * 1024); } while (0)
#define PG8_MMA(ai, bj, At, Bt) do { __builtin_amdgcn_s_setprio(1); _Pragma("unroll") for (int m = 0; m < 4; ++m) _Pragma("unroll") for (int n = 0; n < 2; ++n) _Pragma("unroll") for (int k = 0; k < 2; ++k) \
        acc[ai][bj][m][n] = __builtin_amdgcn_mfma_f32_16x16x32_bf16(Bt[n][k], At[m][k], acc[ai][bj][m][n], 0, 0, 0); __builtin_amdgcn_s_setprio(0); } while (0)
#define PG8_WAIT_V(n) asm volatile("s_waitcnt vmcnt(" #n ")" ::: "memory")
#define PG8_WAIT_L(n) asm volatile("s_waitcnt lgkmcnt(" #n ")" ::: "memory")
#define PG8_BAR __builtin_amdgcn_s_barrier()
#define PG8_SCHED __builtin_amdgcn_sched_barrier(0)
    Unit cur, nxt; int ui = 0;
    if (!S.next(0, cur)) return;
    f32x4 acc[2][2][4][2];
#pragma unroll
    for (int a = 0; a < 2; ++a)
#pragma unroll
        for (int b = 0; b < 2; ++b)
#pragma unroll
            for (int m = 0; m < 4; ++m)
#pragma unroll
                for (int n = 0; n < 2; ++n) acc[a][b][m][n] = (f32x4){0.f, 0.f, 0.f, 0.f};
    bf16x8 At[4][2], B0[2][2], B1[2][2];
    const char* cA = S.aptr(cur); const char* cB = S.bptr(cur);
    PG8_STAGE(PG8_SB(0, 0), cB, voffB); PG8_STAGE(PG8_SA(0, 0), cA, voffA); PG8_STAGE(PG8_SB(0, 1), cB + hstep, voffB); PG8_STAGE(PG8_SA(0, 1), cA + hstep, voffA);
    if (wr == 1) PG8_BAR;
    PG8_WAIT_V(4); PG8_BAR;
    PG8_STAGE(PG8_SB(1, 0), cB + kstep, voffB); PG8_STAGE(PG8_SA(1, 0), cA + kstep, voffA); PG8_STAGE(PG8_SB(1, 1), cB + hstep + kstep, voffB);
    PG8_WAIT_V(6); PG8_BAR;
    for (;;) {
        const bool has_next = S.next(ui + 1, nxt);
        const char* nA = has_next ? S.aptr(nxt) : cA; const char* nB = has_next ? S.bptr(nxt) : cB;
        for (int t = 0; t < nt; t += 2) {
            const bool last = (t == nt - 2);
            const char* a1 = cA + (size_t)(t + 1) * kstep;
            const char* a2 = last ? nA : cA + (size_t)(t + 2) * kstep; const char* b2 = last ? nB : cB + (size_t)(t + 2) * kstep;
            const char* a3 = a2 + kstep; const char* b3 = b2 + kstep;
            PG8_LDB(B0, 0, 0); PG8_SCHED; PG8_LDA(At, 0, 0); PG8_STAGE(PG8_SA(1, 1), a1 + hstep, voffA);
            PG8_WAIT_L(8); PG8_BAR; PG8_WAIT_L(0); PG8_MMA(0, 0, At, B0); PG8_BAR; PG8_SCHED;
            PG8_LDB(B1, 0, 1); PG8_STAGE(PG8_SB(0, 0), b2, voffB);
            PG8_BAR; PG8_WAIT_L(0); PG8_MMA(0, 1, At, B1); PG8_BAR;
            PG8_LDA(At, 0, 1); PG8_STAGE(PG8_SA(0, 0), a2, voffA);
            PG8_BAR; PG8_WAIT_L(0); PG8_MMA(1, 0, At, B0); PG8_BAR; PG8_SCHED;
            PG8_STAGE(PG8_SB(0, 1), b2 + hstep, voffB);
            PG8_WAIT_V(6); PG8_BAR; PG8_MMA(1, 1, At, B1); PG8_BAR;
            PG8_LDB(B0, 1, 0); PG8_SCHED; PG8_LDA(At, 1, 0); PG8_STAGE(PG8_SA(0, 1), a2 + hstep, voffA);
            PG8_WAIT_L(8); PG8_BAR; PG8_WAIT_L(0); PG8_MMA(0, 0, At, B0); PG8_BAR; PG8_SCHED;
            PG8_LDB(B1, 1, 1); PG8_STAGE(PG8_SB(1, 0), b3, voffB);
            PG8_BAR; PG8_WAIT_L(0); PG8_MMA(0, 1, At, B1); PG8_BAR;
            PG8_LDA(At, 1, 1); PG8_STAGE(PG8_SA(1, 0), a3, voffA);
            PG8_BAR; PG8_WAIT_L(0); PG8_MMA(1, 0, At, B0); PG8_BAR; PG8_SCHED;
            PG8_STAGE(PG8_SB(1, 1), b3 + hstep, voffB);
            PG8_WAIT_V(6); PG8_BAR; PG8_MMA(1, 1, At, B1); PG8_BAR;
        }
        if constexpr (!Epi::AFTER_DRAIN) E(acc, cur, wr, wc, fr, fq);
        if (!has_next) break;
#pragma unroll
        for (int a = 0; a < 2; ++a)
#pragma unroll
            for (int b = 0; b < 2; ++b)
#pragma unroll
                for (int m = 0; m < 4; ++m)
#pragma unroll
                    for (int n = 0; n < 2; ++n) acc[a][b][m][n] = (f32x4){0.f, 0.f, 0.f, 0.f};
        cur = nxt; cA = nA; cB = nB; ++ui;
    }
    PG8_WAIT_V(0);
    if (wr == 0) PG8_BAR;
    PG8_BAR;
    if constexpr (Epi::AFTER_DRAIN) E.fused(acc, cur, wr, wc, fr, fq, (char*)lds);
#undef PG8_SA
#undef PG8_SB
#undef PG8_STAGE
#undef PG8_LDA
#undef PG8_LDB
#undef PG8_MMA
#undef PG8_WAIT_V
#undef PG8_WAIT_L
#undef PG8_BAR
#undef PG8_SCHED
}

template <int MODE> struct EpiRows {
  static constexpr bool AFTER_DRAIN = false;
  bf16_t* O; int ldc; const float* rstd;
  __device__ __forceinline__ void operator()(const f32x4 (&acc)[2][2][4][2], const Unit& u, int wr, int wc, int fr, int fq) const {
    const int row0 = u.pm * BM + wr * 64 + fr, col0 = u.pn * BM + wc * 32 + 8 * fq;
#pragma unroll
    for (int ai = 0; ai < 2; ++ai)
#pragma unroll
      for (int m = 0; m < 4; ++m) {
        const int row = row0 + ai * HALF + m * 16;
        const float rs = (MODE == 1 || MODE == 2) ? rstd[row] : 1.0f;
        bf16_t* rowp = O + (size_t)row * ldc + col0;
#pragma unroll
        for (int bj = 0; bj < 2; ++bj) {
          f32x4 v0 = acc[ai][bj][m][0] * rs, v1 = acc[ai][bj][m][1] * rs;
          if (MODE == 2 || MODE == 3) {
#pragma unroll
            for (int j = 0; j < 4; ++j) { const float a = fmaxf(v0[j], 0.f), b = fmaxf(v1[j], 0.f); v0[j] = a * a; v1[j] = b * b; }
          }
          u32x4 w; w.x = cvt_pk_bf16(v0[0], v0[1]); w.y = cvt_pk_bf16(v0[2], v0[3]); w.z = cvt_pk_bf16(v1[0], v1[1]); w.w = cvt_pk_bf16(v1[2], v1[3]);
          *(u32x4*)(rowp + bj * HALF) = w;
        }
      }
  }
};

struct EpiRetQKV {
  static constexpr bool AFTER_DRAIN = false;
  unsigned char* ws; int qd; const float* ldf; const float* ldb;
  __device__ __forceinline__ void operator()(const f32x4 (&acc)[2][2][4][2], const Unit& u, int wr, int wc, int fr, int fq) const {
    bf16_t* QQ = reinterpret_cast<bf16_t*>(ws + off_qq(qd & 1)); bf16_t* KQ = reinterpret_cast<bf16_t*>(ws + OFF_KQ);
    bf16_t* KFT = reinterpret_cast<bf16_t*>(ws + OFF_KFT); bf16_t* KBT = reinterpret_cast<bf16_t*>(ws + OFF_KBT);
    bf16_t* VT = reinterpret_cast<bf16_t*>(ws + off_vt(qd & 1));
    const float* rstd_q = reinterpret_cast<const float*>(ws + OFF_RSTD) + qd * 4096;
    if (u.kind == 0) {
      EpiRows<1> e{QQ, 1024, rstd_q};
      e(acc, u, wr, wc, fr, fq);
    } else {
      const int r0 = wr * 64 + fr;
      const bool isk = u.pm < 4;
#pragma unroll
      for (int bj = 0; bj < 2; ++bj) {
        const int lt0 = u.pn * BM + bj * HALF + wc * 32 + 8 * fq;
        const int lb = lt0 >> 11, s0 = lt0 & 2047;
        const f32x4 ra = *(const f32x4*)(rstd_q + lt0), rb = *(const f32x4*)(rstd_q + lt0 + 4);
        if (isk) {
          const int h = u.pm;
          const float lf2 = ldf[h] * LOG2E, lb2 = ldb[h] * LOG2E;
          const int j0 = s0 & 255;
          const float f0 = exp2f(lf2 * (float)(255 - j0)), gfi = exp2f(-lf2), b0 = exp2f(lb2 * (float)j0), gb = exp2f(lb2);
          float df[8], db[8];
          df[0] = f0; db[0] = b0;
#pragma unroll
          for (int e = 1; e < 8; ++e) { df[e] = df[e - 1] * gfi; db[e] = db[e - 1] * gb; }
#pragma unroll
          for (int ai = 0; ai < 2; ++ai)
#pragma unroll
            for (int m = 0; m < 4; ++m) {
              const int d = r0 + ai * HALF + m * 16;
              const f32x4 v0 = acc[ai][bj][m][0] * ra, v1 = acc[ai][bj][m][1] * rb;
              const size_t o = ((size_t)((((lb * 4 + h) * 2 + (d >> 7)) * 8 + (s0 >> 8)) * 128 + (d & 127))) * 256 + (s0 & 255);
              u32x4 w;
              w.x = cvt_pk_bf16(v0[0] * df[0], v0[1] * df[1]); w.y = cvt_pk_bf16(v0[2] * df[2], v0[3] * df[3]);
              w.z = cvt_pk_bf16(v1[0] * df[4], v1[1] * df[5]); w.w = cvt_pk_bf16(v1[2] * df[6], v1[3] * df[7]);
              *(u32x4*)(KFT + o) = w;
              w.x = cvt_pk_bf16(v0[0] * db[0], v0[1] * db[1]); w.y = cvt_pk_bf16(v0[2] * db[2], v0[3] * db[3]);
              w.z = cvt_pk_bf16(v1[0] * db[4], v1[1] * db[5]); w.w = cvt_pk_bf16(v1[2] * db[6], v1[3] * db[7]);
              *(u32x4*)(KBT + o) = w;
              bf16_t* kq = KQ + (size_t)lt0 * 1024 + h * 256 + d;
#pragma unroll
              for (int e = 0; e < 4; ++e) { kq[(size_t)e * 1024] = (bf16_t)f2bf(v0[e]); kq[(size_t)(e + 4) * 1024] = (bf16_t)f2bf(v1[e]); }
            }
        } else {
#pragma unroll
          for (int ai = 0; ai < 2; ++ai)
#pragma unroll
            for (int m = 0; m < 4; ++m) {
              const int vrow = (u.pm - 4) * 256 + r0 + ai * HALF + m * 16;
              const int h = vrow >> 9, ee = vrow & 511;
              const f32x4 v0 = acc[ai][bj][m][0] * ra, v1 = acc[ai][bj][m][1] * rb;
              u32x4 w; w.x = cvt_pk_bf16(v0[0], v0[1]); w.y = cvt_pk_bf16(v0[2], v0[3]); w.z = cvt_pk_bf16(v1[0], v1[1]); w.w = cvt_pk_bf16(v1[2], v1[3]);
              *(u32x4*)(VT + ((size_t)((((lb * 4 + h) * 4 + (ee >> 7)) * 8 + (s0 >> 8)) * 128 + (ee & 127))) * 256 + (s0 & 255)) = w;
            }
        }
      }
    }
  }
};

struct EpiAttnIn {
  static constexpr bool AFTER_DRAIN = false;
  unsigned char* ws;
  __device__ __forceinline__ void operator()(const f32x4 (&acc)[2][2][4][2], const Unit& u, int wr, int wc, int fr, int fq) const {
    bf16_t* AQ = reinterpret_cast<bf16_t*>(ws + OFF_AQ); bf16_t* AK = reinterpret_cast<bf16_t*>(ws + OFF_AK);
    bf16_t* AVT = reinterpret_cast<bf16_t*>(ws + OFF_AVT);
    const float* rstd = reinterpret_cast<const float*>(ws + OFF_RSTD);
    if (u.kind == 0) {
      if (u.pn < 4) { EpiRows<1> e{AQ, 1024, rstd}; e(acc, u, wr, wc, fr, fq); }
      else { Unit u2 = u; u2.pn = 0; EpiRows<1> e{AK, 256, rstd}; e(acc, u2, wr, wc, fr, fq); }
    } else {
      const int r0 = wr * 64 + fr;
#pragma unroll
      for (int bj = 0; bj < 2; ++bj) {
        const int t0 = u.pn * BM + bj * HALF + wc * 32 + 8 * fq;
        const int b = t0 >> 11, s0 = t0 & 2047;
        const f32x4 ra = *(const f32x4*)(rstd + t0), rb = *(const f32x4*)(rstd + t0 + 4);
#pragma unroll
        for (int ai = 0; ai < 2; ++ai)
#pragma unroll
          for (int m = 0; m < 4; ++m) {
            const int vrow = r0 + ai * HALF + m * 16;
            const int kvh = vrow >> 6, d = vrow & 63;
            const f32x4 v0 = acc[ai][bj][m][0] * ra, v1 = acc[ai][bj][m][1] * rb;
            u32x4 w; w.x = cvt_pk_bf16(v0[0], v0[1]); w.y = cvt_pk_bf16(v0[2], v0[3]); w.z = cvt_pk_bf16(v1[0], v1[1]); w.w = cvt_pk_bf16(v1[2], v1[3]);
            *(u32x4*)(AVT + ((size_t)((b * 4 + kvh) * 64 + d)) * 2048 + s0) = w;
          }
      }
    }
  }
};

template <bool PRE, bool FIN, bool SQ> struct EpiResid {
  static constexpr bool AFTER_DRAIN = true;
  unsigned char* ws; const float* gpost; int inst; int set; float* out;
  __device__ __forceinline__ float exchange(float* part, float* xch, unsigned* flag, const Unit& u, const int tid) const {
    float mine = 0.f;
    if (tid < 256) {
      mine = (part[tid * 4 + 0] + part[tid * 4 + 1]) + (part[tid * 4 + 2] + part[tid * 4 + 3]);
      __hip_atomic_store(xch + (size_t)(u.pm * 4 + u.pn) * 256 + tid, mine, __ATOMIC_RELAXED, __HIP_MEMORY_SCOPE_AGENT);
    }
    asm volatile("s_waitcnt vmcnt(0)" ::: "memory");
    __syncthreads();
    if (tid == 0) {
      __hip_atomic_fetch_add(flag, 1u, __ATOMIC_RELAXED, __HIP_MEMORY_SCOPE_AGENT);
      const unsigned need = 4u * (unsigned)(inst + 1);
      unsigned spins = 0;
      while (__hip_atomic_load(flag, __ATOMIC_RELAXED, __HIP_MEMORY_SCOPE_AGENT) < need) { __builtin_amdgcn_s_sleep(1); if (++spins > (1u << 24)) break; }
    }
    __syncthreads();
    float tot = mine;
    if (tid < 256) {
#pragma unroll
      for (int q = 0; q < 4; ++q)
        if (q != u.pn) tot += __hip_atomic_load(xch + (size_t)(u.pm * 4 + q) * 256 + tid, __ATOMIC_RELAXED, __HIP_MEMORY_SCOPE_AGENT);
    }
    return tot;
  }
  __device__ __forceinline__ void fused(const f32x4 (&acc)[2][2][4][2], const Unit& u, int wr, int wc, int fr, int fq, char* lds) const {
    const int tid = opaque_tid();
    unsigned char* ws = opaque_ptr(this->ws);
    float* part = reinterpret_cast<float*>(lds);
    float* rr = part + 1024;
    float* part2 = part + 1280;
    bf16_t* xb = reinterpret_cast<bf16_t*>(ws + OFF_XB);
    float* rstd = reinterpret_cast<float*>(ws + OFF_RSTD);
    float* xchA = reinterpret_cast<float*>(ws + OFF_XCH2) + (size_t)set * 2 * 64 * 4 * 256;
    float* xchB = xchA + 64 * 4 * 256;
    unsigned* flA = reinterpret_cast<unsigned*>(ws + OFF_XFLAG2) + set * 2 * 64 * 16 + u.pm * 16;
    unsigned* flB = flA + 64 * 16;
#pragma unroll
    for (int ai = 0; ai < 2; ++ai)
#pragma unroll
      for (int m = 0; m < 4; ++m) {
        float ss = 0.f;
#pragma unroll
        for (int bj = 0; bj < 2; ++bj)
#pragma unroll
          for (int n = 0; n < 2; ++n) { const f32x4 v = acc[ai][bj][m][n]; ss += v[0] * v[0] + v[1] * v[1] + v[2] * v[2] + v[3] * v[3]; }
        if (PRE) { const float ps = rstd[(size_t)u.pm * BM + ai * HALF + wr * 64 + m * 16 + fr]; ss *= ps * ps; }
        ss += __shfl_xor(ss, 16);
        ss += __shfl_xor(ss, 32);
        if (fq == 0) part[(ai * HALF + wr * 64 + m * 16 + fr) * 4 + wc] = ss;
      }
    __syncthreads();
    {
      const float tot = exchange(part, xchA, flA, u, tid);
      if (tid < 256) rr[tid] = rsqrtf(tot * (1.0f / 1024.0f) + EPSV);
    }
    __syncthreads();
#pragma unroll
    for (int ai = 0; ai < 2; ++ai)
#pragma unroll
      for (int m = 0; m < 4; ++m) {
        const int rowl = ai * HALF + wr * 64 + m * 16 + fr;
        const size_t row = (size_t)u.pm * BM + rowl;
        const float rn = PRE ? rr[rowl] * rstd[row] : rr[rowl];
        float sx = 0.f;
#pragma unroll
        for (int bj = 0; bj < 2; ++bj) {
          const int col = u.pn * BM + bj * HALF + wc * 32 + 8 * fq;
          bf16_t* xp = xb + row * 1024 + col;
          const uint4 xv = *reinterpret_cast<const uint4*>(xp);
          const f32x4 g0 = *reinterpret_cast<const f32x4*>(gpost + col), g1 = *reinterpret_cast<const f32x4*>(gpost + col + 4);
          const f32x4 h0 = acc[ai][bj][m][0], h1 = acc[ai][bj][m][1];
          uint4 o;
          { const float a0 = bf2f(xv.x & 0xffffu) + h0[0] * rn * g0[0], a1 = bf2f(xv.x >> 16) + h0[1] * rn * g0[1];
            const float a2 = bf2f(xv.y & 0xffffu) + h0[2] * rn * g0[2], a3 = bf2f(xv.y >> 16) + h0[3] * rn * g0[3];
            if (FIN) *reinterpret_cast<f32x4*>(out + row * 1024 + col) = f32x4{a0, a1, a2, a3};
            else { sx += (a0 * a0 + a1 * a1) + (a2 * a2 + a3 * a3); o.x = pack2(a0, a1); o.y = pack2(a2, a3); } }
          { const float a0 = bf2f(xv.z & 0xffffu) + h1[0] * rn * g1[0], a1 = bf2f(xv.z >> 16) + h1[1] * rn * g1[1];
            const float a2 = bf2f(xv.w & 0xffffu) + h1[2] * rn * g1[2], a3 = bf2f(xv.w >> 16) + h1[3] * rn * g1[3];
            if (FIN) *reinterpret_cast<f32x4*>(out + row * 1024 + col + 4) = f32x4{a0, a1, a2, a3};
            else { sx += (a0 * a0 + a1 * a1) + (a2 * a2 + a3 * a3); o.z = pack2(a0, a1); o.w = pack2(a2, a3); } }
          if (!FIN) *reinterpret_cast<uint4*>(xp) = o;
        }
        sx += __shfl_xor(sx, 16);
        sx += __shfl_xor(sx, 32);
        if (fq == 0) part2[rowl * 4 + wc] = sx;
      }
    if (!FIN) {
      __syncthreads();
      const float tot = exchange(part2, xchB, flB, u, tid);
      const float mean = tot * (1.0f / 1024.0f) + EPSV;
      if (tid < 256 && u.pn == 0) rstd[(size_t)u.pm * BM + tid] = SQ ? 1.0f / mean : rsqrtf(mean);
    }
  }
};
}

struct ConvItem { const float* src; const float* gain; bf16_t* dst; int K, N, kt, nt; float scale; };
__device__ __forceinline__ void conv_decode(const Params& p, unsigned char* ws, int layer, int it, const float*& src, const float*& gain, bf16_t*& dst,
                                            int& K, int& N, int& kt, int& nt, float& scale) {
  const bool ret = (layer & 1) == 0;
  const int li = layer >> 1;
  const int Nin = ret ? 6144 : 1536;
  const int Kout = ret ? 2048 : 1024;
  const int nIn = 16 * (Nin / 64), nOut = (Kout / 64) * 16;
  scale = 1.0f; gain = nullptr;
  if (it < nIn) {
    const int ntn = Nin / 64; nt = it % ntn; kt = it / ntn;
    const int n = nt * 64;
    if (ret) { if (n >= 1024 && n < 2048) scale = 0.0625f; } else { if (n < 1024) scale = 0.125f * LOG2E; }
    src = ret ? p.w_in_ret + (size_t)li * 1024 * 6144 : p.w_in_attn + (size_t)li * 1024 * 1536;
    K = 1024; N = Nin; gain = p.g_pre_mix + layer * 1024; dst = reinterpret_cast<bf16_t*>(ws + OFF_WIN);
  } else if (it < nIn + nOut) {
    const int j = it - nIn; nt = j % 16; kt = j / 16;
    src = ret ? p.w_out_ret + (size_t)li * 2048 * 1024 : p.w_out_attn + (size_t)li * 1024 * 1024;
    K = Kout; N = 1024; dst = reinterpret_cast<bf16_t*>(ws + OFF_WOUT);
  } else if (it < nIn + nOut + 1024) {
    const int j = it - nIn - nOut; nt = j % 64; kt = j / 64;
    src = p.w_up + (size_t)layer * 1024 * 4096; K = 1024; N = 4096; gain = p.g_pre_mlp + layer * 1024; dst = reinterpret_cast<bf16_t*>(ws + OFF_WUP);
  } else {
    const int j = it - nIn - nOut - 1024; nt = j % 16; kt = j / 16;
    src = p.w_down + (size_t)layer * 4096 * 1024; K = 4096; N = 1024; dst = reinterpret_cast<bf16_t*>(ws + OFF_WDN);
  }
}
#define CONV_LOAD(it_, V0, V1, V2, V3, G0, G1, G2, G3, DST, KK, KT, NT) do { \
    const float* _src; const float* _gain; int _N; float _sc; \
    conv_decode(p, ws, layer, (it_), _src, _gain, DST, KK, _N, KT, NT, _sc); \
    const int _kk = tid >> 4, _n4 = (tid & 15) * 4; \
    const float* _b = _src + (size_t)(KT * 64 + _kk) * _N + NT * 64 + _n4; \
    V0 = *reinterpret_cast<const float4*>(_b);                       V1 = *reinterpret_cast<const float4*>(_b + (size_t)16 * _N); \
    V2 = *reinterpret_cast<const float4*>(_b + (size_t)32 * _N);     V3 = *reinterpret_cast<const float4*>(_b + (size_t)48 * _N); \
    G0 = (_gain ? _gain[KT * 64 + _kk] : 1.0f) * _sc;      G1 = (_gain ? _gain[KT * 64 + _kk + 16] : 1.0f) * _sc; \
    G2 = (_gain ? _gain[KT * 64 + _kk + 32] : 1.0f) * _sc; G3 = (_gain ? _gain[KT * 64 + _kk + 48] : 1.0f) * _sc; } while (0)
#define CONV_PUT1(V, G, i_) do { const int _kk = (tid >> 4) + (i_) * 16, _n4 = (tid & 15) * 4; \
    tl[_kk * 65 + _n4 + 0] = V.x * G; tl[_kk * 65 + _n4 + 1] = V.y * G; tl[_kk * 65 + _n4 + 2] = V.z * G; tl[_kk * 65 + _n4 + 3] = V.w * G; } while (0)
#define CONV_STORE(V0, V1, V2, V3, G0, G1, G2, G3, DST, KK, KT, NT) do { \
    __syncthreads(); \
    CONV_PUT1(V0, G0, 0); CONV_PUT1(V1, G1, 1); CONV_PUT1(V2, G2, 2); CONV_PUT1(V3, G3, 3); \
    __syncthreads(); \
    _Pragma("unroll") for (int _i = 0; _i < 2; ++_i) { \
      const int _c = tid + _i * 256, _n = _c >> 3, _kc = _c & 7; \
      uint4 _o; \
      _o.x = pack2(tl[(_kc * 8 + 0) * 65 + _n], tl[(_kc * 8 + 1) * 65 + _n]); \
      _o.y = pack2(tl[(_kc * 8 + 2) * 65 + _n], tl[(_kc * 8 + 3) * 65 + _n]); \
      _o.z = pack2(tl[(_kc * 8 + 4) * 65 + _n], tl[(_kc * 8 + 5) * 65 + _n]); \
      _o.w = pack2(tl[(_kc * 8 + 6) * 65 + _n], tl[(_kc * 8 + 7) * 65 + _n]); \
      *reinterpret_cast<uint4*>(DST + (size_t)(NT * 64 + _n) * KK + KT * 64 + _kc * 8) = _o; } } while (0)

__device__ __forceinline__ void convert_layer(const Params& p, int layer, char* lds, const int which = 3, const int b0 = 0, const int nb = 256) {
  unsigned char* ws = opaque_ptr(p.ws);
  const int tidf = opaque_tid();
  const int half = tidf >> 8, tid = tidf & 255;
  float* tl = reinterpret_cast<float*>(lds + half * 65536);
  const bool ret = (layer & 1) == 0;
  const int nIn = 16 * ((ret ? 6144 : 1536) / 64), nOut = ((ret ? 2048 : 1024) / 64) * 16;
  const int first = (which & 1) ? 0 : nIn + nOut;
  const int total = ((which & 2) ? nIn + nOut + 2048 : nIn + nOut) - first;
  for (int q4 = (int)blockIdx.x - b0; q4 < total / 4; q4 += nb) {
    const int ita = first + q4 * 4 + half * 2, itb = ita + 1;
    float4 a0, a1, a2, a3, b0, b1, b2, b3; float ga0, ga1, ga2, ga3, gb0, gb1, gb2, gb3;
    bf16_t* da; bf16_t* db; int Ka, Kb, kta, ktb, nta, ntb;
    CONV_LOAD(ita, a0, a1, a2, a3, ga0, ga1, ga2, ga3, da, Ka, kta, nta);
    CONV_LOAD(itb, b0, b1, b2, b3, gb0, gb1, gb2, gb3, db, Kb, ktb, ntb);
    CONV_STORE(a0, a1, a2, a3, ga0, ga1, ga2, ga3, da, Ka, kta, nta);
    CONV_STORE(b0, b1, b2, b3, gb0, gb1, gb2, gb3, db, Kb, ktb, ntb);
  }
}
#undef CONV_LOAD
#undef CONV_PUT1
#undef CONV_STORE

__device__ __forceinline__ void phase_init(const Params& p) {
  const int tid = opaque_tid();
  const int lane = tid & 63, wid = tid >> 6;
  bf16_t* xb = reinterpret_cast<bf16_t*>(p.ws + OFF_XB);
  float* rstd = reinterpret_cast<float*>(p.ws + OFF_RSTD);
  for (int row = blockIdx.x * 8 + wid; row < T_TOK; row += gridDim.x * 8) {
    float ss = 0.f;
#pragma unroll
    for (int i = 0; i < 4; ++i) {
      const size_t o = (size_t)row * 1024 + i * 256 + lane * 4;
      const float4 v = *reinterpret_cast<const float4*>(p.x + o);
      ss += v.x * v.x + v.y * v.y + v.z * v.z + v.w * v.w;
      uint2 b; b.x = pack2(v.x, v.y); b.y = pack2(v.z, v.w);
      *reinterpret_cast<uint2*>(xb + o) = b;
    }
    ss = wave_sum(ss);
    if (lane == 0) rstd[row] = rsqrtf(ss * (1.0f / 1024.0f) + EPSV);
  }
}

template <bool FINAL, bool SQ>
__device__ __forceinline__ void phase_resid(const Params& p, const float* __restrict__ gpost) {
  const int tid = opaque_tid();
  const int lane = tid & 63, wid = tid >> 6;
  bf16_t* xb = reinterpret_cast<bf16_t*>(p.ws + OFF_XB);
  const bf16_t* hbuf = reinterpret_cast<const bf16_t*>(p.ws + OFF_HB);
  float* rstd = reinterpret_cast<float*>(p.ws + OFF_RSTD);
  constexpr int NR = 4;
  float4 gv[4];
#pragma unroll
  for (int i = 0; i < 4; ++i) gv[i] = *reinterpret_cast<const float4*>(gpost + i * 256 + lane * 4);
  for (int row0 = (blockIdx.x * 8 + wid) * NR; row0 < T_TOK; row0 += gridDim.x * 8 * NR) {
    uint2 hb[NR][4], xx[NR][4];
#pragma unroll
    for (int q = 0; q < NR; ++q)
#pragma unroll
      for (int i = 0; i < 4; ++i) {
        const size_t o = (size_t)(row0 + q) * 1024 + i * 256 + lane * 4;
        hb[q][i] = *reinterpret_cast<const uint2*>(hbuf + o);
        xx[q][i] = *reinterpret_cast<const uint2*>(xb + o);
      }
#pragma unroll
    for (int q = 0; q < NR; ++q) {
      float hv[16], xv[16];
      float ss = 0.f;
#pragma unroll
      for (int i = 0; i < 4; ++i) {
        hv[i * 4 + 0] = bf2f(hb[q][i].x & 0xffffu); hv[i * 4 + 1] = bf2f(hb[q][i].x >> 16);
        hv[i * 4 + 2] = bf2f(hb[q][i].y & 0xffffu); hv[i * 4 + 3] = bf2f(hb[q][i].y >> 16);
        xv[i * 4 + 0] = bf2f(xx[q][i].x & 0xffffu); xv[i * 4 + 1] = bf2f(xx[q][i].x >> 16);
        xv[i * 4 + 2] = bf2f(xx[q][i].y & 0xffffu); xv[i * 4 + 3] = bf2f(xx[q][i].y >> 16);
#pragma unroll
        for (int e = 0; e < 4; ++e) ss += hv[i * 4 + e] * hv[i * 4 + e];
      }
      ss = wave_sum(ss);
      const float rh = rsqrtf(ss * (1.0f / 1024.0f) + EPSV);
      float sx = 0.f;
#pragma unroll
      for (int i = 0; i < 4; ++i) {
        const int c = i * 256 + lane * 4;
        xv[i * 4 + 0] += hv[i * 4 + 0] * rh * gv[i].x; xv[i * 4 + 1] += hv[i * 4 + 1] * rh * gv[i].y;
        xv[i * 4 + 2] += hv[i * 4 + 2] * rh * gv[i].z; xv[i * 4 + 3] += hv[i * 4 + 3] * rh * gv[i].w;
#pragma unroll
        for (int e = 0; e < 4; ++e) sx += xv[i * 4 + e] * xv[i * 4 + e];
        const size_t o = (size_t)(row0 + q) * 1024 + c;
        if (FINAL) {
          *reinterpret_cast<float4*>(p.out + o) = float4{xv[i * 4 + 0], xv[i * 4 + 1], xv[i * 4 + 2], xv[i * 4 + 3]};
        } else {
          uint2 b; b.x = pack2(xv[i * 4 + 0], xv[i * 4 + 1]); b.y = pack2(xv[i * 4 + 2], xv[i * 4 + 3]);
          *reinterpret_cast<uint2*>(xb + o) = b;
        }
      }
      if (!FINAL) {
        sx = wave_sum(sx);
        if (lane == 0) rstd[row0 + q] = SQ ? 1.0f / (sx * (1.0f / 1024.0f) + EPSV) : rsqrtf(sx * (1.0f / 1024.0f) + EPSV);
      }
    }
  }
}

__device__ __forceinline__ void ret_normalize(const Params& p, int qd) {
  unsigned char* ws = opaque_ptr(p.ws);
  const int tid = opaque_tid();
  const int lane = tid & 63, wid = tid >> 6;
  bf16_t* ABUF = reinterpret_cast<bf16_t*>(ws + OFF_ABUF);
  const float* opart = reinterpret_cast<const float*>(ws + OFF_OPART);
  for (int row = qd * 4096 + blockIdx.x * 8 + wid; row < (qd + 1) * 4096; row += gridDim.x * 8) {
#pragma unroll
    for (int i = 0; i < 4; ++i) {
      const float4 a = *reinterpret_cast<const float4*>(opart + (size_t)row * 32 + i * 8);
      const float4 b = *reinterpret_cast<const float4*>(opart + (size_t)row * 32 + i * 8 + 4);
      const float s = ((a.x + a.y) + (a.z + a.w)) + ((b.x + b.y) + (b.z + b.w));
      const float r = rsqrtf(s * (1.0f / 512.0f) + EPSV);
      bf16_t* ap = ABUF + (size_t)row * 2048 + i * 512 + lane * 8;
      uint4 v = *reinterpret_cast<const uint4*>(ap);
      uint4 o;
      o.x = pack2(bf2f(v.x & 0xffffu) * r, bf2f(v.x >> 16) * r);
      o.y = pack2(bf2f(v.y & 0xffffu) * r, bf2f(v.y >> 16) * r);
      o.z = pack2(bf2f(v.z & 0xffffu) * r, bf2f(v.z >> 16) * r);
      o.w = pack2(bf2f(v.w & 0xffffu) * r, bf2f(v.w >> 16) * r);
      *reinterpret_cast<uint4*>(ap) = o;
    }
  }
}


__device__ __forceinline__ void ret_s_tile(const Params& p, int li, int idx, unsigned char* ws, char* lds, const int tid, const int par) {
  const bf16_t* QQ = reinterpret_cast<const bf16_t*>(ws + off_qq(par));
  const bf16_t* KQ = reinterpret_cast<const bf16_t*>(ws + OFF_KQ);
  bf16_t* PQ = reinterpret_cast<bf16_t*>(ws + OFF_PQ);
  const int lane = tid & 63, wid = tid >> 6, wm = wid >> 2, wn = wid & 3, r = lane & 15, quad = lane >> 4;
  const int ni = idx & 1, mi = (idx >> 1) & 1, c = (idx >> 2) & 7, h = (idx >> 5) & 3, lb = idx >> 7;
  const bf16_t* A = QQ + (size_t)(lb * 2048 + c * 256 + mi * 128) * 1024 + h * 256;
  const bf16_t* B = KQ + (size_t)(lb * 2048 + c * 256 + ni * 128) * 1024 + h * 256;
  f32x4 acc[4][2];
#pragma unroll
  for (int ms = 0; ms < 4; ++ms) { acc[ms][0] = f32x4{0.f, 0.f, 0.f, 0.f}; acc[ms][1] = f32x4{0.f, 0.f, 0.f, 0.f}; }
  gemm8<2>(acc, 4, A, B, nullptr, nullptr, nullptr, 1024 | (1024 << 16), 0.f, 0.f, 0.f, 0.f, 0.f, 0.f, 0.f, 0.f, lds, tid);
  const float lf2 = p.ldf[li * 4 + h] * LOG2E, lb2 = p.ldb[li * 4 + h] * LOG2E;
  bf16_t* dst = PQ + ((size_t)(((lb * 4 + h) * 8 + c) * 256 + mi * 128)) * 256 + ni * 128;
#pragma unroll
  for (int ms = 0; ms < 4; ++ms) {
    const int m = wm * 64 + ms * 16 + r;
    const int i = mi * 128 + m;
#pragma unroll
    for (int ns = 0; ns < 2; ++ns) {
      const int n0 = wn * 32 + ns * 16 + quad * 4;
      const int j0 = ni * 128 + n0;
      const f32x4 v = acc[ms][ns];
      float o[4];
#pragma unroll
      for (int e = 0; e < 4; ++e) {
        const int diff = i - (j0 + e);
        const float dec = diff >= 0 ? exp2f(lf2 * (float)diff) : exp2f(-lb2 * (float)diff);
        o[e] = v[e] * dec;
      }
      uint2 ov; ov.x = pack2(o[0], o[1]); ov.y = pack2(o[2], o[3]);
      *reinterpret_cast<uint2*>(dst + (size_t)m * 256 + n0) = ov;
    }
  }
}

__device__ __forceinline__ void ret_states_chain(const Params& p, int layer, int qd, char* lds) {
  unsigned char* ws = opaque_ptr(p.ws);
  const bf16_t* KFT = reinterpret_cast<const bf16_t*>(ws + OFF_KFT);
  const bf16_t* KBT = reinterpret_cast<const bf16_t*>(ws + OFF_KBT);
  const bf16_t* VT = reinterpret_cast<const bf16_t*>(ws + off_vt(qd & 1));
  bf16_t* RQ = reinterpret_cast<bf16_t*>(ws + OFF_RQ);
  const int li = layer >> 1;
  const int tid = opaque_tid();
  const int pair = blockIdx.x & 7, sub = blockIdx.x >> 3;
  const int ki = sub & 1, vi = (sub >> 1) & 3, dir = (sub >> 3) & 1, h = pair & 3, lb = pair >> 2;
  const bf16_t* Ab = VT + ((size_t)((lb * 4 + h) * 4 + vi)) * 8 * 32768;
  const bf16_t* Bb = (dir ? KBT : KFT) + ((size_t)((lb * 4 + h) * 2 + ki)) * 8 * 32768;
  const float lg2 = (dir ? p.ldb[li * 4 + h] : p.ldf[li * 4 + h]) * LOG2E;
  const float cd = exp2f(lg2 * 256.0f);
  const bf16_t* Rbase = RQ + ((size_t)((((lb * 4 + h) * 2 + dir) * 7) * 512 + vi * 128)) * 256 + ki * 128;
  f32x4 acc[4][2];
#pragma unroll
  for (int ms = 0; ms < 4; ++ms) { acc[ms][0] = f32x4{0.f, 0.f, 0.f, 0.f}; acc[ms][1] = f32x4{0.f, 0.f, 0.f, 0.f}; }
  gemm8<0>(acc, 28, Ab, Bb, Rbase, nullptr, nullptr, dir, cd, 0.f, 0.f, 0.f, 0.f, 0.f, 0.f, 0.f, lds, tid);
}
__device__ __forceinline__ void ret_states_gate(const Params& p, int qd, char* lds) {
  unsigned char* ws = opaque_ptr(p.ws);
  pg8::Sched2 S;
  S.A0 = (const char*)(reinterpret_cast<const bf16_t*>(ws + OFF_XB) + (size_t)qd * 4096 * 1024);
  S.B0 = (const char*)(reinterpret_cast<const bf16_t*>(ws + OFF_WIN) + (size_t)4096 * 1024);
  S.A1 = S.A0; S.B1 = S.B0;
  S.nM0 = 16; S.nN0 = 8; S.nM1 = 0; S.nN1 = 0; S.G = 128; S.c = (int)blockIdx.x - 128; S.tstep = (size_t)256 * 1024 * 2;
  pg8::EpiRows<1> E{reinterpret_cast<bf16_t*>(ws + OFF_ABUF) + (size_t)qd * 4096 * 2048, 2048, reinterpret_cast<const float*>(ws + OFF_RSTD) + qd * 4096};
  pg8::gemm_phase((PG8_LAS unsigned char*)lds, 1024, S, E);
}
__device__ __forceinline__ void ret_states_s(const Params& p, int layer, int qd, char* lds) {
  unsigned char* ws = opaque_ptr(p.ws);
  const int tid = opaque_tid();
  const int li = layer >> 1;
  ret_s_tile(p, li, ((int)blockIdx.x & 7) * 32 + ((int)blockIdx.x >> 3), ws, lds, tid, qd & 1);
}

__device__ __forceinline__ void ret_output(const Params& p, int layer, int qd, char* lds) {
  const int inst = (layer >> 1) * 4 + qd;
  unsigned char* ws = opaque_ptr(p.ws);
  const bf16_t* QQ = reinterpret_cast<const bf16_t*>(ws + off_qq(qd & 1));
  const bf16_t* VT = reinterpret_cast<const bf16_t*>(ws + off_vt(qd & 1));
  const bf16_t* RQ = reinterpret_cast<const bf16_t*>(ws + OFF_RQ);
  const bf16_t* PQ = reinterpret_cast<const bf16_t*>(ws + OFF_PQ);
  bf16_t* ABUF = reinterpret_cast<bf16_t*>(ws + OFF_ABUF);
  float* opart = reinterpret_cast<float*>(ws + OFF_OPART);
  const int li = layer >> 1;
  const int tid = opaque_tid();
  const int lane = tid & 63, wid = tid >> 6, wm = wid >> 2, wn = wid & 3, r = lane & 15, quad = lane >> 4;
  {
    const int xcd = blockIdx.x & 7, pslot = blockIdx.x >> 3;
    const int slot = pslot < 8 ? pslot + 4 : (pslot < 12 ? pslot - 8 : (pslot < 20 ? pslot : (pslot < 24 ? pslot + 8 : pslot - 4)));
    const int grp = xcd * 16 + (slot >> 1);
    const int vp = slot & 1, tt = grp & 15, h = (grp >> 4) & 3, lb = grp >> 6;
    const int c = tt >> 1, mi = tt & 1;
    const bf16_t* Aq = QQ + (size_t)(lb * 2048 + tt * 128) * 1024 + h * 256;
    const float lf2 = p.ldf[li * 4 + h] * LOG2E, lb2 = p.ldb[li * 4 + h] * LOG2E;
    f32x4 acc[4][4];
    zero_acc(acc);
    {
      const bf16_t* Rf = RQ + ((size_t)((((lb * 4 + h) * 2 + 0) * 7 + (c > 0 ? c - 1 : 0)) * 512 + vp * 256)) * 256;
      const bf16_t* Rb = RQ + ((size_t)((((lb * 4 + h) * 2 + 1) * 7 + (c < 7 ? c : 0)) * 512 + vp * 256)) * 256;
      const bf16_t* Pp = PQ + ((size_t)(((lb * 4 + h) * 8 + c) * 256 + mi * 128)) * 256;
      const bf16_t* V0 = VT + ((size_t)(((lb * 4 + h) * 4 + vp * 2) * 8 + c)) * 32768;
      const bf16_t* V1 = VT + ((size_t)(((lb * 4 + h) * 4 + vp * 2 + 1) * 8 + c)) * 32768;
      float f00, f01, f02, f03, f10, f11, f12, f13;
#define RO_FAC(ms, F0, F1) do { const int i = mi * 128 + wm * 64 + (ms) * 16 + r; \
        const float ef = lf2 * (float)(i + 1), eb = lb2 * (float)(256 - i); \
        F0 = (c < 7) ? exp2f(ef - eb) : exp2f(ef);     \
        F1 = exp2f(eb); } while (0)
      RO_FAC(0, f00, f10); RO_FAC(1, f01, f11); RO_FAC(2, f02, f12); RO_FAC(3, f03, f13);
#undef RO_FAC
      const int nseg = (c > 0 ? 1 : 0) + (c < 7 ? 1 : 0) + 1;
      gemm8w(acc, nseg * 4, Aq, Rf, Rb, Pp, V0, V1, c, f00, f01, f02, f03, f10, f11, f12, f13, lds, tid);
    }
    {
      float* part = reinterpret_cast<float*>(lds);
      float ssv[4];
#pragma unroll
      for (int ms = 0; ms < 4; ++ms) {
        float ss = 0.f;
#pragma unroll
        for (int ns = 0; ns < 4; ++ns) { const f32x4 o = acc[ms][ns]; ss += o[0] * o[0] + o[1] * o[1] + o[2] * o[2] + o[3] * o[3]; }
        ss += __shfl_xor(ss, 16);
        ss += __shfl_xor(ss, 32);
        ssv[ms] = ss;
        if (quad == 0) part[(wm * 64 + ms * 16 + r) * 4 + wn] = ss;
      }
      __syncthreads();
      float* xch = reinterpret_cast<float*>(ws + OFF_XCH);
      unsigned* xflag = reinterpret_cast<unsigned*>(ws + OFF_XFLAG) + grp * 16;
      float mine = 0.f;
      if (tid < 128) {
        mine = (part[tid * 4 + 0] + part[tid * 4 + 1]) + (part[tid * 4 + 2] + part[tid * 4 + 3]);
        __hip_atomic_store(xch + (size_t)(grp * 2 + vp) * 128 + tid, mine, __ATOMIC_RELAXED, __HIP_MEMORY_SCOPE_AGENT);
      }
      asm volatile("s_waitcnt vmcnt(0)" ::: "memory");
      __syncthreads();
      if (tid == 0) {
        __hip_atomic_fetch_add(xflag, 1u, __ATOMIC_RELAXED, __HIP_MEMORY_SCOPE_AGENT);
        const unsigned need = 2u * (unsigned)(inst + 1);
        unsigned spins = 0;
        while (__hip_atomic_load(xflag, __ATOMIC_RELAXED, __HIP_MEMORY_SCOPE_AGENT) < need) {
          __builtin_amdgcn_s_sleep(1);
          if (++spins > (1u << 24)) break;
        }
      }
      __syncthreads();
      if (tid < 128) {
        const float other = __hip_atomic_load(xch + (size_t)(grp * 2 + (1 - vp)) * 128 + tid, __ATOMIC_RELAXED, __HIP_MEMORY_SCOPE_AGENT);
        part[512 + tid] = rsqrtf((mine + other) * (1.0f / 512.0f) + EPSV);
      }
      __syncthreads();
      float rnv[4];
#pragma unroll
      for (int ms = 0; ms < 4; ++ms) rnv[ms] = part[512 + wm * 64 + ms * 16 + r];
      __syncthreads();
#pragma unroll
      for (int ms = 0; ms < 4; ++ms) {
        const int m = wm * 64 + ms * 16 + r;
        const int t = qd * 4096 + lb * 2048 + tt * 128 + m;
        const float rn = rnv[ms];
#pragma unroll
        for (int ns = 0; ns < 4; ++ns) {
          const int col = h * 512 + vp * 256 + wn * 64 + ns * 16 + quad * 4;
          const f32x4 o = acc[ms][ns] * rn;
          bf16_t* gp = ABUF + (size_t)t * 2048 + col;
          const uint2 gb = *reinterpret_cast<const uint2*>(gp);
          const float g0 = bf2f(gb.x & 0xffffu), g1 = bf2f(gb.x >> 16), g2 = bf2f(gb.y & 0xffffu), g3 = bf2f(gb.y >> 16);
          uint2 ov;
          ov.x = pack2(g0 / (1.f + __expf(-g0)) * o[0], g1 / (1.f + __expf(-g1)) * o[1]);
          ov.y = pack2(g2 / (1.f + __expf(-g2)) * o[2], g3 / (1.f + __expf(-g3)) * o[3]);
          *reinterpret_cast<uint2*>(gp) = ov;
        }
      }
      (void)ssv;
    }
  }
}

constexpr int AT_VPITCH = 656;
constexpr int AT_VOFF = 320 * 128;
template <bool INTERIOR>
__device__ __forceinline__ void attn_qtile(const bf16_t* AQ, bf16_t* AO, const char* lds, const int b, const int t0, const int qo, const int head,
                                           const int r, const int quad, const float sink2, const float slope2, const float (&bd)[4]) {
      const bf16_t* qp = AQ + (size_t)(b * 2048 + t0 + qo + r) * 1024 + head * 64 + quad * 8;
      const bf16x8 qf0 = *reinterpret_cast<const bf16x8*>(qp);
      const bf16x8 qf1 = *reinterpret_cast<const bf16x8*>(qp + 32);
      f32x4 s[18];
      s[17] = f32x4{0.f, 0.f, 0.f, 0.f};
#pragma unroll
      for (int kt = 0; kt < 17; ++kt) {
        const int row = qo + kt * 16 + r;
        const char* kp = lds + row * 128;
        const bf16x8 kf0 = *reinterpret_cast<const bf16x8*>(kp + (((0 + quad) ^ (row & 7)) << 4));
        const bf16x8 kf1 = *reinterpret_cast<const bf16x8*>(kp + (((4 + quad) ^ (row & 7)) << 4));
        f32x4 a = {0.f, 0.f, 0.f, 0.f};
        a = __builtin_amdgcn_mfma_f32_16x16x32_bf16(kf0, qf0, a, 0, 0, 0);
        a = __builtin_amdgcn_mfma_f32_16x16x32_bf16(kf1, qf1, a, 0, 0, 0);
        s[kt] = a;
      }
      float mx = sink2;
      if (INTERIOR) {
#pragma unroll
        for (int kt = 0; kt < 17; ++kt) {
#pragma unroll
          for (int j = 0; j < 4; ++j) {
            const float e = bd[j] - (float)(kt * 16);
            float sc = fmaf(-slope2, fabsf(e), s[kt][j]);
            if (kt == 0) sc = (e <= 128.0f) ? sc : -1e30f;
            if (kt == 16) sc = (e >= -128.0f) ? sc : -1e30f;
            s[kt][j] = sc;
            mx = fmaxf(mx, sc);
          }
        }
      } else {
        const float tqf = (float)(t0 + qo + r);
        const float hi = fminf(128.0f, tqf), lo = fmaxf(-128.0f, tqf - 2047.0f);
#pragma unroll
        for (int kt = 0; kt < 17; ++kt) {
#pragma unroll
          for (int j = 0; j < 4; ++j) {
            const float e = bd[j] - (float)(kt * 16);
            const float sc = (e <= hi && e >= lo) ? fmaf(-slope2, fabsf(e), s[kt][j]) : -1e30f;
            s[kt][j] = sc;
            mx = fmaxf(mx, sc);
          }
        }
      }
      mx = fmaxf(mx, __shfl_xor(mx, 16));
      mx = fmaxf(mx, __shfl_xor(mx, 32));
      float sum = 0.f;
#pragma unroll
      for (int kt = 0; kt < 17; ++kt) {
#pragma unroll
        for (int j = 0; j < 4; ++j) {
          const float pv = __builtin_amdgcn_exp2f(s[kt][j] - mx);
          s[kt][j] = pv;
          sum += pv;
        }
      }
      sum += __shfl_xor(sum, 16);
      sum += __shfl_xor(sum, 32);
      sum += __builtin_amdgcn_exp2f(sink2 - mx);
      const float inv = 1.0f / sum;
      f32x4 o[4];
#pragma unroll
      for (int dt = 0; dt < 4; ++dt) o[dt] = f32x4{0.f, 0.f, 0.f, 0.f};
#pragma unroll
      for (int st = 0; st < 9; ++st) {
        union { uint4 u; bf16x8 v; } pb;
        pb.u.x = pack2(s[2 * st][0], s[2 * st][1]);
        pb.u.y = pack2(s[2 * st][2], s[2 * st][3]);
        pb.u.z = pack2(s[2 * st + 1][0], s[2 * st + 1][1]);
        pb.u.w = pack2(s[2 * st + 1][2], s[2 * st + 1][3]);
        const int kl = qo + st * 32 + quad * 4;
#pragma unroll
        for (int dt = 0; dt < 4; ++dt) {
          const char* vp = lds + AT_VOFF + (dt * 16 + r) * AT_VPITCH + kl * 2;
          const uint2 xa = *reinterpret_cast<const uint2*>(vp);
          const uint2 xb2 = *reinterpret_cast<const uint2*>(vp + 32);
          union { uint4 u; bf16x8 v; } af;
          af.u.x = xa.x; af.u.y = xa.y; af.u.z = xb2.x; af.u.w = xb2.y;
          o[dt] = __builtin_amdgcn_mfma_f32_16x16x32_bf16(af.v, pb.v, o[dt], 0, 0, 0);
        }
      }
#pragma unroll
      for (int dt = 0; dt < 4; ++dt) {
        uint2 ov; ov.x = pack2(o[dt][0] * inv, o[dt][1] * inv); ov.y = pack2(o[dt][2] * inv, o[dt][3] * inv);
        *reinterpret_cast<uint2*>(AO + (size_t)(b * 2048 + t0 + qo + r) * 1024 + head * 64 + dt * 16 + quad * 4) = ov;
      }
}

__device__ __forceinline__ void attn_core(const Params& p, int layer, char* lds) {
  unsigned char* ws = opaque_ptr(p.ws);
  const bf16_t* AQ = reinterpret_cast<const bf16_t*>(ws + OFF_AQ);
  const bf16_t* AK = reinterpret_cast<const bf16_t*>(ws + OFF_AK);
  const bf16_t* AVT = reinterpret_cast<const bf16_t*>(ws + OFF_AVT);
  bf16_t* AO = reinterpret_cast<bf16_t*>(ws + OFF_AO);
  const int li = layer >> 1;
  const int tid = opaque_tid();
  const int lane = tid & 63, wid8 = tid >> 6, wid = wid8 & 3, r = lane & 15, quad = lane >> 4;
  for (int k4 = 0; k4 < 4; ++k4) {
    const int item = ((int)blockIdx.x & 7) * 128 + ((int)blockIdx.x >> 3) * 4 + k4;
    const int qb = item & 31, kvh = (item >> 5) & 3, b = item >> 7;
    const int t0 = qb * 64, ks = t0 - 128;
    __syncthreads();
#pragma unroll
    for (int i = 0; i < 5; ++i) {
      const int c = tid + i * 512;
      {
        const int row = c >> 3, kc = c & 7, key = ks + row;
        uint4 v = {0u, 0u, 0u, 0u};
        if (key >= 0 && key < 2048) v = *reinterpret_cast<const uint4*>(AK + (size_t)(b * 2048 + key) * 256 + kvh * 64 + kc * 8);
        *reinterpret_cast<uint4*>(lds + row * 128 + ((kc ^ (row & 7)) << 4)) = v;
      }
      {
        const int d = c / 40, kc = c - d * 40, key = ks + kc * 8;
        uint4 v = {0u, 0u, 0u, 0u};
        if (key >= 0 && key < 2048) v = *reinterpret_cast<const uint4*>(AVT + ((size_t)((b * 4 + kvh) * 64 + d)) * 2048 + key);
        *reinterpret_cast<uint4*>(lds + AT_VOFF + d * AT_VPITCH + kc * 16) = v;
      }
    }
    __syncthreads();
    const int head = kvh * 4 + wid;
    const float sink2 = p.sink[li * 16 + head] * LOG2E;
    const float slope2 = exp2f(-0.5f * (float)(head + 1)) * LOG2E;
    float bd[4];
#pragma unroll
    for (int j = 0; j < 4; ++j) bd[j] = (float)(r + 128 - quad * 4 - j);
#pragma unroll 1
    for (int jq = 0; jq < 2; ++jq) {
      const int qo = ((wid8 >> 2) * 2 + jq) * 16;
      if ((t0 >= 128) && (t0 + 192 <= 2048)) attn_qtile<true>(AQ, AO, lds, b, t0, qo, head, r, quad, sink2, slope2, bd);
      else                                  attn_qtile<false>(AQ, AO, lds, b, t0, qo, head, r, quad, sink2, slope2, bd);
    }
  }
}

template <int MODE>
__device__ __forceinline__ void big_gemm(char* lds, const bf16_t* A, const bf16_t* W, int M, int N, int K, bf16_t* C, int ldc, const float* rstd) {
  pg8::Sched2 S;
  S.A0 = (const char*)A; S.B0 = (const char*)W; S.A1 = S.A0; S.B1 = S.B0;
  S.nM0 = M / 256; S.nN0 = N / 256; S.nM1 = 0; S.nN1 = 0; S.G = (int)gridDim.x; S.c = (int)blockIdx.x; S.tstep = (size_t)256 * K * 2;
  pg8::EpiRows<MODE> E{C, ldc, rstd};
  pg8::gemm_phase(( PG8_LAS unsigned char*)lds, K, S, E);
}

template <bool PRE, bool FIN, bool SQ>
__device__ __forceinline__ void proj_resid(char* lds, unsigned char* ws, const bf16_t* A, const bf16_t* W, int K, const float* gpost, int inst, int set, float* out) {
  pg8::Sched2 S;
  S.A0 = (const char*)A; S.B0 = (const char*)W; S.A1 = S.A0; S.B1 = S.B0;
  S.nM0 = 64; S.nN0 = 4; S.nM1 = 0; S.nN1 = 0; S.G = (int)gridDim.x; S.c = (int)blockIdx.x; S.tstep = (size_t)256 * K * 2;
  pg8::EpiResid<PRE, FIN, SQ> E{ws, gpost, inst, set, out};
  pg8::gemm_phase((PG8_LAS unsigned char*)lds, K, S, E);
}

__global__ void __launch_bounds__(512, 2) fwd_megakernel(Params p, int never) {
  extern __shared__ __attribute__((aligned(16))) char lds[];
  volatile LAS unsigned* st = (volatile LAS unsigned*)(lds + LDS_STAGE);
  if (threadIdx.x == 0) { st[0] = 0u; st[1] = 0u; st[2] = 0u; st[3] = 0u; }
  __syncthreads();
  if (never == 0x7fffabcd) { cg::this_grid().sync(); }
    (void)xcd_barrier_post(reinterpret_cast<unsigned*>(p.ws + OFF_BAR), st);

  phase_init(p);
  convert_layer(p, 0, lds);
  xcd_barrier(XcdBarrier{reinterpret_cast<unsigned*>(p.ws + OFF_BAR), xb_xcc_id(), (volatile LAS unsigned*)(lds + LDS_STAGE)});

#pragma unroll 1
  for (int layer = 0; layer < 4; ++layer) {
    if ((layer & 1) == 0) {
      const int li = layer >> 1;
#define RET_QKV(qd_) do { \
          pg8::SchedRetQKV S; \
          S.A0 = (const char*)((reinterpret_cast<bf16_t*>(p.ws + OFF_XB)) + (size_t)(qd_) * 4096 * 1024); S.B0 = (const char*)(reinterpret_cast<const bf16_t*>(p.ws + OFF_WIN)); \
          S.A1 = (const char*)((reinterpret_cast<const bf16_t*>(p.ws + OFF_WIN)) + (size_t)1024 * 1024); S.B1 = S.A0; \
          S.tstep = (size_t)256 * 1024 * 2; S.xcd = (int)blockIdx.x & 7; S.slot = (int)blockIdx.x >> 3; \
          pg8::EpiRetQKV E{(p.ws), (qd_), p.ldf + li * 4, p.ldb + li * 4}; \
          pg8::gemm_phase((PG8_LAS unsigned char*)lds, 1024, S, E); } while (0)
      if (layer > 0) { convert_layer(p, layer, lds, 2); __syncthreads(); }
      RET_QKV(0);
      xcd_barrier(XcdBarrier{reinterpret_cast<unsigned*>(p.ws + OFF_BAR), xb_xcc_id(), (volatile LAS unsigned*)(lds + LDS_STAGE)});
#pragma unroll 1
      for (int qd = 0; qd < 4; ++qd) {
        if (blockIdx.x < 128) ret_states_chain(p, layer, qd, lds);
        else ret_states_gate(p, qd, lds);
        ret_states_s(p, layer, qd, lds);
        xcd_barrier(XcdBarrier{reinterpret_cast<unsigned*>(p.ws + OFF_BAR), xb_xcc_id(), (volatile LAS unsigned*)(lds + LDS_STAGE)});
        ret_output(p, layer, qd, lds);
        if (qd < 3) RET_QKV(qd + 1);
        xcd_barrier(XcdBarrier{reinterpret_cast<unsigned*>(p.ws + OFF_BAR), xb_xcc_id(), (volatile LAS unsigned*)(lds + LDS_STAGE)});
      }
#undef RET_QKV
      proj_resid<false, false, true>(lds, (p.ws), reinterpret_cast<const bf16_t*>((p.ws) + OFF_ABUF), (reinterpret_cast<const bf16_t*>(p.ws + OFF_WOUT)), 2048, p.g_post_mix + layer * 1024, layer, 0, nullptr);
      xcd_barrier(XcdBarrier{reinterpret_cast<unsigned*>(p.ws + OFF_BAR), xb_xcc_id(), (volatile LAS unsigned*)(lds + LDS_STAGE)});
    } else {
      if (blockIdx.x >= 128) { convert_layer(p, layer, lds, 2, 128, 128); __syncthreads(); }
      {
        pg8::Sched2 S;
        S.A0 = (const char*)(reinterpret_cast<bf16_t*>(p.ws + OFF_XB)); S.B0 = (const char*)(reinterpret_cast<const bf16_t*>(p.ws + OFF_WIN));
        S.A1 = (const char*)((reinterpret_cast<const bf16_t*>(p.ws + OFF_WIN)) + (size_t)1280 * 1024); S.B1 = (const char*)(reinterpret_cast<bf16_t*>(p.ws + OFF_XB));
        S.nM0 = 64; S.nN0 = 5; S.nM1 = 1; S.nN1 = 64; S.G = (int)gridDim.x; S.c = (int)blockIdx.x; S.tstep = (size_t)256 * 1024 * 2;
        pg8::EpiAttnIn E{(p.ws)};
        pg8::gemm_phase((PG8_LAS unsigned char*)lds, 1024, S, E);
      }
      xcd_barrier(XcdBarrier{reinterpret_cast<unsigned*>(p.ws + OFF_BAR), xb_xcc_id(), (volatile LAS unsigned*)(lds + LDS_STAGE)});
      attn_core(p, layer, lds);
      xcd_barrier(XcdBarrier{reinterpret_cast<unsigned*>(p.ws + OFF_BAR), xb_xcc_id(), (volatile LAS unsigned*)(lds + LDS_STAGE)});
      proj_resid<false, false, true>(lds, (p.ws), reinterpret_cast<const bf16_t*>((p.ws) + OFF_AO), (reinterpret_cast<const bf16_t*>(p.ws + OFF_WOUT)), 1024, p.g_post_mix + layer * 1024, layer, 0, nullptr);
      xcd_barrier(XcdBarrier{reinterpret_cast<unsigned*>(p.ws + OFF_BAR), xb_xcc_id(), (volatile LAS unsigned*)(lds + LDS_STAGE)});
    }
    if (layer < 3) { convert_layer(p, layer + 1, lds, 1); __syncthreads(); }
    big_gemm<3>(lds, (reinterpret_cast<bf16_t*>(p.ws + OFF_XB)), reinterpret_cast<const bf16_t*>((p.ws) + OFF_WUP), 16384, 4096, 1024, reinterpret_cast<bf16_t*>((p.ws) + OFF_HID), 4096, nullptr);
    xcd_barrier(XcdBarrier{reinterpret_cast<unsigned*>(p.ws + OFF_BAR), xb_xcc_id(), (volatile LAS unsigned*)(lds + LDS_STAGE)});
    if (layer < 3) {
      proj_resid<true, false, false>(lds, (p.ws), reinterpret_cast<const bf16_t*>((p.ws) + OFF_HID), reinterpret_cast<const bf16_t*>((p.ws) + OFF_WDN), 4096,
                                     p.g_post_mlp + layer * 1024, layer, 1, nullptr);
      xcd_barrier(XcdBarrier{reinterpret_cast<unsigned*>(p.ws + OFF_BAR), xb_xcc_id(), (volatile LAS unsigned*)(lds + LDS_STAGE)});
    } else {
      proj_resid<true, true, false>(lds, (p.ws), reinterpret_cast<const bf16_t*>((p.ws) + OFF_HID), reinterpret_cast<const bf16_t*>((p.ws) + OFF_WDN), 4096,
                                    p.g_post_mlp + layer * 1024, layer, 1, p.out);
    }
  }
}


extern "C" void kernel_launch(void* const* d_in, const int* in_sizes, int n_in, void* d_out, int out_size,
                              void* d_ws, size_t ws_size, hipStream_t stream) {
  static int grid_blocks = 0;
  if (!grid_blocks) {
    int dev = 0, cus = 0, per_cu = 0;
    (void)hipGetDevice(&dev);
    (void)hipDeviceGetAttribute(&cus, hipDeviceAttributeMultiprocessorCount, dev);
    (void)hipFuncSetAttribute((const void*)fwd_megakernel, hipFuncAttributeMaxDynamicSharedMemorySize, LDS_BYTES);
    (void)hipOccupancyMaxActiveBlocksPerMultiprocessor(&per_cu, (const void*)fwd_megakernel, 512, LDS_BYTES);
    if (per_cu < 1) fprintf(stderr, "kernel_launch: occupancy query reports %d blocks per CU\n", per_cu);
    grid_blocks = 256;
    if (cus < 256) fprintf(stderr, "kernel_launch: %d CUs < 256: the grid will not be co-resident\n", cus);
    if (ws_size < WS_NEED) fprintf(stderr, "kernel_launch: workspace too small: %zu < %zu\n", ws_size, (size_t)WS_NEED);
  }
  (void)hipMemsetAsync((char*)d_ws + OFF_BAR, 0, 16384, stream);
  (void)hipMemsetAsync((char*)d_ws + OFF_XFLAG, 0, 8192 + 16384, stream);
  Params p{};
  p.x = (const float*)d_in[0]; p.w_in_ret = (const float*)d_in[1]; p.w_out_ret = (const float*)d_in[2];
  p.ldf = (const float*)d_in[3]; p.ldb = (const float*)d_in[4]; p.w_in_attn = (const float*)d_in[5];
  p.w_out_attn = (const float*)d_in[6]; p.sink = (const float*)d_in[7]; p.g_pre_mix = (const float*)d_in[8];
  p.g_post_mix = (const float*)d_in[9]; p.g_pre_mlp = (const float*)d_in[10]; p.g_post_mlp = (const float*)d_in[11];
  p.w_up = (const float*)d_in[12]; p.w_down = (const float*)d_in[13];
  p.out = (float*)d_out; p.ws = (unsigned char*)d_ws;
  int never = 0;
  void* args[] = {&p, &never};
  hipError_t e = hipLaunchCooperativeKernel((const void*)fwd_megakernel, dim3(grid_blocks), dim3(512), args, LDS_BYTES, stream);
  if (e != hipSuccess) fprintf(stderr, "cooperative launch failed: %s (grid %d)\n", hipGetErrorString(e), grid_blocks);
}
```
